# Optimizing an MI355X kernel written in HIP

```python
import jax
import jax.numpy as jnp
from jax import lax
import numpy as np

D_MODEL = 1024
BATCH = 1
SEQ = 16384
DEPTH = 4

GRID_W = 64
CTX_LEN = 256
HEAD_DIM = 64
Q_BLOCK = 128
ROPE_BASE = 10000.0
EPS = 1e-6
NEG_INF = -1e30
N_MOD = 9
FFN_RES = 0.5
D_FF = 2816

MLA_HEADS = 8
MLA_Q_RANK = 256
MLA_KV_RANK = 128
MLA_NOPE = 64
MLA_ROPE = 32
MLA_V = 64
GQA_HEADS = 8
GQA_KV_HEADS = 2
SWA_HEADS = 8
SWA_KV_HEADS = 2
WINDOW = 128
NA_HEADS = 8
NA_ROWS = 8
NA_COLS = 16

N_AB = (DEPTH + 1) // 2
N_CD = DEPTH // 2
AB_IN = MLA_Q_RANK + MLA_KV_RANK + MLA_ROPE + (GQA_HEADS + 2 * GQA_KV_HEADS) * HEAD_DIM
AB_OUT = MLA_HEADS * MLA_V + GQA_HEADS * HEAD_DIM
CD_IN = (SWA_HEADS + 2 * SWA_KV_HEADS) * HEAD_DIM + 3 * NA_HEADS * HEAD_DIM
CD_OUT = (SWA_HEADS + NA_HEADS) * HEAD_DIM

kernel_name = 'hybrid_mla_gqa_swa_na_macaron_dit'


def rms_norm(x, g):
    xf = x.astype(jnp.float32)
    y = xf * lax.rsqrt(jnp.mean(xf * xf, axis=-1, keepdims=True) + EPS)
    return y.astype(x.dtype) * g


def ada_in(x, mod, slot, g):
    return rms_norm(x, g) * (1 + mod[:, 3 * slot + 1, None, :]) + mod[:, 3 * slot, None, :]


def ada_out(x, y, mod, slot, g, w):
    return x + w * mod[:, 3 * slot + 2, None, :] * rms_norm(y, g)


def swiglu(h, wg, wu, wd):
    return (jax.nn.silu(h @ wg) * (h @ wu)) @ wd


def split_cols(t, sizes):
    return jnp.split(t, np.cumsum(sizes)[:-1].tolist(), axis=-1)


def axial_rope_tables(n_tok, rot_dim, dtype):
    t = jnp.arange(n_tok, dtype=jnp.int32)
    row = (t // GRID_W).astype(jnp.float32)
    col = (t % GRID_W).astype(jnp.float32)
    per_axis = rot_dim // 2
    inv = ROPE_BASE ** (-jnp.arange(0, per_axis, 2, dtype=jnp.float32) / per_axis)
    ang = jnp.concatenate([row[:, None] * inv, col[:, None] * inv], axis=-1)
    return jnp.cos(ang).astype(dtype), jnp.sin(ang).astype(dtype)


def apply_rope(x, cos, sin):
    x1, x2 = jnp.split(x, 2, axis=-1)
    cs, sn = cos[None, :, None, :], sin[None, :, None, :]
    return jnp.concatenate([x1 * cs - x2 * sn, x1 * sn + x2 * cs], axis=-1)


def neighbourhood_tables(rows):
    kr = min(NA_ROWS, rows)
    n_tok = rows * GRID_W
    t = jnp.arange(n_tok, dtype=jnp.int32)
    r, col = t // GRID_W, t % GRID_W
    r0 = jnp.clip(r - kr // 2, 0, rows - kr)
    c0 = jnp.clip(col - NA_COLS // 2, 0, GRID_W - NA_COLS)
    key_r = r0[:, None, None] + jnp.arange(kr, dtype=jnp.int32)[None, :, None]
    key_c = c0[:, None, None] + jnp.arange(NA_COLS, dtype=jnp.int32)[None, None, :]
    idx = (key_r * GRID_W + key_c).reshape(n_tok, kr * NA_COLS)
    rel = ((key_r - r[:, None, None] + NA_ROWS - 1) * (2 * NA_COLS - 1)
           + (key_c - col[:, None, None] + NA_COLS - 1)).reshape(n_tok, kr * NA_COLS)
    return idx, rel


def softmax_with_sink(logits, sink):
    if sink is None:
        return jax.nn.softmax(logits, axis=-1)
    s = jnp.broadcast_to(sink.astype(jnp.float32), logits.shape[:-1] + (1,))
    return jax.nn.softmax(jnp.concatenate([logits, s], axis=-1), axis=-1)[..., :-1]


def dense_gqa(q, k, v, sink=None):
    B, Q, H, d = q.shape
    Hk = k.shape[2]
    qg = q.reshape(B, Q, Hk, H // Hk, d)
    logits = jnp.einsum('bqhgd,bkhd->bhgqk', qg, k).astype(jnp.float32) * (d ** -0.5)
    p = softmax_with_sink(logits, sink).astype(v.dtype)
    o = jnp.einsum('bhgqk,bkhd->bqhgd', p, v)
    return o.reshape(B, Q, H, v.shape[-1])


def to_blocks(q):
    B, S, H, d = q.shape
    return q.reshape(B, S // Q_BLOCK, Q_BLOCK, H, d).transpose(1, 0, 2, 3, 4)


def from_blocks(o):
    nb, B, QB, H, d = o.shape
    return o.transpose(1, 0, 2, 3, 4).reshape(B, nb * QB, H, d)


def blocked_dense(q, k, v):
    return from_blocks(lax.map(lambda qi: dense_gqa(qi, k, v), to_blocks(q)))


def windowed_gqa(q, k, v, kc, vc, sink):
    B, S, H, d = q.shape
    Hk = k.shape[2]
    G = H // Hk
    nc = kc.shape[1]
    span = Q_BLOCK + 2 * WINDOW
    pad = ((0, 0), (WINDOW, WINDOW), (0, 0), (0, 0))
    kp, vp = jnp.pad(k, pad), jnp.pad(v, pad)
    scale = d ** -0.5

    def block(args):
        qi, b = args
        start = b * Q_BLOCK
        kw = lax.dynamic_slice_in_dim(kp, start, span, axis=1)
        vw = lax.dynamic_slice_in_dim(vp, start, span, axis=1)
        qpos = start + jnp.arange(Q_BLOCK, dtype=jnp.int32)
        kpos = start - WINDOW + jnp.arange(span, dtype=jnp.int32)
        valid = ((jnp.abs(qpos[:, None] - kpos[None, :]) <= WINDOW)
                 & (kpos[None, :] >= 0) & (kpos[None, :] < S))
        qg = qi.reshape(B, Q_BLOCK, Hk, G, d)
        lc = jnp.einsum('bqhgd,bkhd->bhgqk', qg, kc).astype(jnp.float32) * scale
        lw = jnp.einsum('bqhgd,bkhd->bhgqk', qg, kw).astype(jnp.float32) * scale
        lw = jnp.where(valid, lw, NEG_INF)
        p = softmax_with_sink(jnp.concatenate([lc, lw], axis=-1), sink).astype(v.dtype)
        o = (jnp.einsum('bhgqk,bkhd->bqhgd', p[..., :nc], vc)
             + jnp.einsum('bhgqk,bkhd->bqhgd', p[..., nc:], vw))
        return o.reshape(B, Q_BLOCK, H, v.shape[-1])

    nb = S // Q_BLOCK
    return from_blocks(lax.map(block, (to_blocks(q), jnp.arange(nb, dtype=jnp.int32))))


def neighbourhood_attend(q, k, v, kc, vc, rpb, nbr_idx, rel_idx):
    B, S, H, d = q.shape
    nb = S // Q_BLOCK
    nk = nbr_idx.shape[1]
    nc = kc.shape[1]
    rpb_flat = rpb.reshape(H, -1)
    scale = d ** -0.5

    def block(args):
        qi, idx, rel = args
        kn, vn = k[:, idx], v[:, idx]
        lc = jnp.einsum('bqhd,bkhd->bhqk', qi, kc).astype(jnp.float32) * scale
        ln = (jnp.einsum('bqhd,bqkhd->bhqk', qi, kn).astype(jnp.float32) * scale
              + rpb_flat[:, rel].astype(jnp.float32)[None])
        p = jax.nn.softmax(jnp.concatenate([lc, ln], axis=-1), axis=-1).astype(v.dtype)
        return (jnp.einsum('bhqk,bkhd->bqhd', p[..., :nc], vc)
                + jnp.einsum('bhqk,bqkhd->bqhd', p[..., nc:], vn))

    xs = (to_blocks(q), nbr_idx.reshape(nb, Q_BLOCK, nk), rel_idx.reshape(nb, Q_BLOCK, nk))
    return from_blocks(lax.map(block, xs))


def ab_mixer(h, hc, w_in, q_norm, w_uq, kv_norm, w_ukv, qn_b, kn_b, w_out, rope_a, rope_h, with_ctx):
    sizes = [MLA_Q_RANK, MLA_KV_RANK, MLA_ROPE, GQA_HEADS * HEAD_DIM,
             GQA_KV_HEADS * HEAD_DIM, GQA_KV_HEADS * HEAD_DIM]

    def project(t, positional):
        Bt, N, _ = t.shape
        cq, ckv, kr, bq, bk, bv = split_cols(t @ w_in, sizes)
        qa = (rms_norm(cq, q_norm) @ w_uq).reshape(Bt, N, MLA_HEADS, MLA_NOPE + MLA_ROPE)
        q_nope, q_rope = jnp.split(qa, [MLA_NOPE], axis=-1)
        kva = (rms_norm(ckv, kv_norm) @ w_ukv).reshape(Bt, N, MLA_HEADS, MLA_NOPE + MLA_V)
        k_nope, va = jnp.split(kva, [MLA_NOPE], axis=-1)
        kr = kr[:, :, None, :]
        bq = rms_norm(bq.reshape(Bt, N, GQA_HEADS, HEAD_DIM), qn_b)
        bk = rms_norm(bk.reshape(Bt, N, GQA_KV_HEADS, HEAD_DIM), kn_b)
        bv = bv.reshape(Bt, N, GQA_KV_HEADS, HEAD_DIM)
        if positional:
            q_rope = apply_rope(q_rope, *rope_a)
            kr = apply_rope(kr, *rope_a)
            bq = apply_rope(bq, *rope_h)
            bk = apply_rope(bk, *rope_h)
        qa = jnp.concatenate([q_nope, q_rope], axis=-1)
        ka = jnp.concatenate([k_nope, jnp.broadcast_to(kr, (Bt, N, MLA_HEADS, MLA_ROPE))], axis=-1)
        return qa, ka, va, bq, bk, bv

    B, S, _ = h.shape
    qa, ka, va, bq, bk, bv = project(h, True)
    qa_c, ka_c, va_c, bq_c, bk_c, bv_c = project(hc, False)
    o_a = blocked_dense(qa, jnp.concatenate([ka_c, ka], axis=1), jnp.concatenate([va_c, va], axis=1))
    o_b = blocked_dense(bq, jnp.concatenate([bk_c, bk], axis=1), jnp.concatenate([bv_c, bv], axis=1))
    y = jnp.concatenate([o_a.reshape(B, S, -1), o_b.reshape(B, S, -1)], axis=-1) @ w_out
    yc = None
    if with_ctx:
        Bc, N = hc.shape[:2]
        oc_a = dense_gqa(qa_c, ka_c, va_c)
        oc_b = dense_gqa(bq_c, bk_c, bv_c)
        yc = jnp.concatenate([oc_a.reshape(Bc, N, -1), oc_b.reshape(Bc, N, -1)], axis=-1) @ w_out
    return y, yc


def cd_mixer(h, hc, w_in, sink, rpb, w_out, rope_h, nbr_idx, rel_idx, with_ctx):
    sizes = [SWA_HEADS * HEAD_DIM, SWA_KV_HEADS * HEAD_DIM, SWA_KV_HEADS * HEAD_DIM,
             NA_HEADS * HEAD_DIM, NA_HEADS * HEAD_DIM, NA_HEADS * HEAD_DIM]

    def project(t, positional):
        Bt, N, _ = t.shape
        parts = split_cols(t @ w_in, sizes)
        cq, ck, cv, dq, dk, dv = [u.reshape(Bt, N, -1, HEAD_DIM) for u in parts]
        if positional:
            cq = apply_rope(cq, *rope_h)
            ck = apply_rope(ck, *rope_h)
        return cq, ck, cv, dq, dk, dv

    B, S, _ = h.shape
    sink_g = sink.reshape(1, SWA_KV_HEADS, SWA_HEADS // SWA_KV_HEADS, 1, 1)
    cq, ck, cv, dq, dk, dv = project(h, True)
    cq_c, ck_c, cv_c, dq_c, dk_c, dv_c = project(hc, False)
    o_c = windowed_gqa(cq, ck, cv, ck_c, cv_c, sink_g)
    o_d = neighbourhood_attend(dq, dk, dv, dk_c, dv_c, rpb, nbr_idx, rel_idx)
    y = jnp.concatenate([o_c.reshape(B, S, -1), o_d.reshape(B, S, -1)], axis=-1) @ w_out
    yc = None
    if with_ctx:
        Bc, N = hc.shape[:2]
        oc_c = dense_gqa(cq_c, ck_c, cv_c, sink_g)
        oc_d = dense_gqa(dq_c, dk_c, dv_c)
        yc = jnp.concatenate([oc_c.reshape(Bc, N, -1), oc_d.reshape(Bc, N, -1)], axis=-1) @ w_out
    return y, yc


def setup_inputs(seed: int = 0) -> dict:
    key = jax.random.key(seed)
    ks = jax.random.split(key, 24)
    f32 = jnp.float32

    def nrm(k, shape, fan_in, s=1.0):
        return jax.random.normal(k, shape, f32) * (s * fan_in ** -0.5)

    def gain(k, shape):
        return 1.0 + 0.1 * jax.random.normal(k, shape, f32)

    return {
        'x': jax.random.normal(ks[0], (BATCH, SEQ, D_MODEL), f32),
        'c': jax.random.normal(ks[1], (BATCH, D_MODEL), f32),
        'ctx': jax.random.normal(ks[2], (BATCH, CTX_LEN, D_MODEL), f32),
        'c_ctx': jax.random.normal(ks[3], (D_MODEL,), f32),
        'ada_w': nrm(ks[4], (DEPTH, D_MODEL, N_MOD * D_MODEL), D_MODEL, 0.5),
        'ada_b': 0.02 * jax.random.normal(ks[5], (DEPTH, N_MOD * D_MODEL), f32),
        'norm_g': gain(ks[6], (DEPTH, 6, D_MODEL)),
        'ffn_w_gate': nrm(ks[7], (DEPTH, 2, D_MODEL, D_FF), D_MODEL),
        'ffn_w_up': nrm(ks[8], (DEPTH, 2, D_MODEL, D_FF), D_MODEL),
        'ffn_w_down': nrm(ks[9], (DEPTH, 2, D_FF, D_MODEL), D_FF),
        'ab_w_in': nrm(ks[10], (N_AB, D_MODEL, AB_IN), D_MODEL),
        'mla_q_norm': gain(ks[11], (N_AB, MLA_Q_RANK)),
        'mla_w_uq': nrm(ks[12], (N_AB, MLA_Q_RANK, MLA_HEADS * (MLA_NOPE + MLA_ROPE)), MLA_Q_RANK),
        'mla_kv_norm': gain(ks[13], (N_AB, MLA_KV_RANK)),
        'mla_w_ukv': nrm(ks[14], (N_AB, MLA_KV_RANK, MLA_HEADS * (MLA_NOPE + MLA_V)), MLA_KV_RANK),
        'gqa_q_norm': gain(ks[15], (N_AB, HEAD_DIM)),
        'gqa_k_norm': gain(ks[16], (N_AB, HEAD_DIM)),
        'ab_w_out': nrm(ks[17], (N_AB, AB_OUT, D_MODEL), AB_OUT),
        'cd_w_in': nrm(ks[18], (N_CD, D_MODEL, CD_IN), D_MODEL),
        'swa_sink': jax.random.normal(ks[19], (N_CD, SWA_HEADS), f32),
        'na_rpb': 0.1 * jax.random.normal(ks[20], (N_CD, NA_HEADS, 2 * NA_ROWS - 1, 2 * NA_COLS - 1), f32),
        'cd_w_out': nrm(ks[21], (N_CD, CD_OUT, D_MODEL), CD_OUT),
    }


def reference(x, c, ctx, c_ctx, ada_w, ada_b, norm_g, ffn_w_gate, ffn_w_up, ffn_w_down,
              ab_w_in, mla_q_norm, mla_w_uq, mla_kv_norm, mla_w_ukv, gqa_q_norm, gqa_k_norm,
              ab_w_out, cd_w_in, swa_sink, na_rpb, cd_w_out):
    B, S, _ = x.shape
    rows = S // GRID_W
    rope_a = axial_rope_tables(S, MLA_ROPE, x.dtype)
    rope_h = axial_rope_tables(S, HEAD_DIM, x.dtype)
    nbr_idx, rel_idx = neighbourhood_tables(rows)
    s_lat = jax.nn.silu(c)
    s_ctx = jax.nn.silu(c_ctx)[None]
    xc = ctx
    for l in range(DEPTH):
        with_ctx = l < DEPTH - 1
        mod = (s_lat @ ada_w[l] + ada_b[l]).reshape(B, N_MOD, -1)
        mod_c = (s_ctx @ ada_w[l] + ada_b[l]).reshape(1, N_MOD, -1)
        g = norm_g[l]
        w1 = (ffn_w_gate[l, 0], ffn_w_up[l, 0], ffn_w_down[l, 0])
        w2 = (ffn_w_gate[l, 1], ffn_w_up[l, 1], ffn_w_down[l, 1])
        x = ada_out(x, swiglu(ada_in(x, mod, 0, g[0]), *w1), mod, 0, g[1], FFN_RES)
        xc = ada_out(xc, swiglu(ada_in(xc, mod_c, 0, g[0]), *w1), mod_c, 0, g[1], FFN_RES)
        h = ada_in(x, mod, 1, g[2])
        hc = ada_in(xc, mod_c, 1, g[2])
        i = l // 2
        if l % 2 == 0:
            y, yc = ab_mixer(h, hc, ab_w_in[i], mla_q_norm[i], mla_w_uq[i], mla_kv_norm[i],
                             mla_w_ukv[i], gqa_q_norm[i], gqa_k_norm[i], ab_w_out[i],
                             rope_a, rope_h, with_ctx)
        else:
            y, yc = cd_mixer(h, hc, cd_w_in[i], swa_sink[i], na_rpb[i], cd_w_out[i],
                             rope_h, nbr_idx, rel_idx, with_ctx)
        x = ada_out(x, y, mod, 1, g[3], 1.0)
        x = ada_out(x, swiglu(ada_in(x, mod, 2, g[4]), *w2), mod, 2, g[5], FFN_RES)
        if with_ctx:
            xc = ada_out(xc, yc, mod_c, 1, g[3], 1.0)
            xc = ada_out(xc, swiglu(ada_in(xc, mod_c, 2, g[4]), *w2), mod_c, 2, g[5], FFN_RES)
    return x
```

```cpp
#include <hip/hip_runtime.h>
#include <hip/hip_cooperative_groups.h>
#include <stdint.h>
#include <string.h>
#include <stdio.h>
namespace cg = cooperative_groups;

#ifndef MULTI
#define MULTI 0
#endif
#ifndef REP_ATTN
#define REP_ATTN 1
#endif
#ifndef REP_GEMM
#define REP_GEMM 1
#endif
#ifndef REP_PREP
#define REP_PREP 1
#endif
#ifndef REP_SYNC
#define REP_SYNC 1
#endif
#ifndef REP_MIXPREP
#define REP_MIXPREP 1
#endif
#ifndef REP_GEMM_MASK
#define REP_GEMM_MASK 0xFFF
#endif
#ifndef FAST_ATTN
#define FAST_ATTN 1
#endif

typedef unsigned short u16;
typedef __attribute__((ext_vector_type(8))) short bf16x8;
typedef __attribute__((ext_vector_type(4))) float f32x4;
typedef __attribute__((ext_vector_type(16))) float f32x16;
typedef __attribute__((ext_vector_type(4))) unsigned u32x4;
typedef __attribute__((ext_vector_type(2))) unsigned u32x2;
#define DI __device__ __forceinline__

constexpr int T_TOK = 16640, S_LAT = 16384, N_CTX = 256, DM = 1024, DFF = 2816;
constexpr int NTHR = 512, NWAVE = 8;
constexpr int SMEM_BYTES = 2 * (256 + 256) * 64 * 2;
constexpr int NMATS = 36;
constexpr int NPH = 2 + 4 * 12;


constexpr size_t al256c(size_t x) { return (x + 255) & ~(size_t)255; }
constexpr size_t SZ_WGU = (size_t)2 * DFF * DM, SZ_WD = (size_t)DM * DFF, SZ_ABIN = (size_t)1280 * DM, SZ_UQ = 768 * 256,
                 SZ_UKV = 1024 * 128, SZ_SQ = (size_t)DM * DM, SZ_CDIN = (size_t)2304 * DM;
constexpr int TR_FFN = 704, TR_OTH = 320 + 48 + 32 + 256 + 576 + 256, TR_TOTAL = 24 * TR_FFN + 2 * TR_OTH;
constexpr size_t OFF_X = 0;
constexpr size_t OFF_MOD = al256c(OFF_X + (size_t)T_TOK * DM * 4);
constexpr size_t OFF_COSH = al256c(OFF_MOD + (size_t)8 * 9216 * 4);
constexpr size_t OFF_SINH = al256c(OFF_COSH + (size_t)S_LAT * 32 * 4);
constexpr size_t OFF_COSA = al256c(OFF_SINH + (size_t)S_LAT * 32 * 4);
constexpr size_t OFF_SINA = al256c(OFF_COSA + (size_t)S_LAT * 16 * 4);
constexpr size_t OFF_H = al256c(OFF_SINA + (size_t)S_LAT * 16 * 4);
constexpr size_t OFF_Y = al256c(OFF_H + (size_t)T_TOK * DM * 2);
constexpr size_t OFF_O = al256c(OFF_Y + (size_t)T_TOK * DM * 2);
constexpr size_t OFF_U = al256c(OFF_O + (size_t)T_TOK * DM * 2);
constexpr size_t OFF_ACT = OFF_U;
constexpr size_t OFF_P = OFF_U;
constexpr size_t OFF_CQN = al256c(OFF_P + (size_t)T_TOK * 2304 * 2);
constexpr size_t OFF_CKVN = al256c(OFF_CQN + (size_t)T_TOK * 256 * 2);
constexpr size_t OFF_KR = al256c(OFF_CKVN + (size_t)T_TOK * 128 * 2);
constexpr size_t OFF_QB = al256c(OFF_KR + (size_t)T_TOK * 32 * 2);
constexpr size_t OFF_KB = al256c(OFF_QB + (size_t)T_TOK * 512 * 2);
constexpr size_t OFF_QA = al256c(OFF_KB + (size_t)T_TOK * 128 * 2);
constexpr size_t OFF_KVA = al256c(OFF_QA + (size_t)T_TOK * 768 * 2);
constexpr size_t OFF_UEND = al256c(OFF_KVA + (size_t)T_TOK * 1024 * 2);
static_assert(OFF_UEND >= OFF_ACT + (size_t)T_TOK * DFF * 2, "union");
constexpr size_t OFF_WGU = OFF_UEND;
constexpr size_t OFF_WD = al256c(OFF_WGU + 8 * SZ_WGU * 2);
constexpr size_t OFF_WABIN = al256c(OFF_WD + 8 * SZ_WD * 2);
constexpr size_t OFF_WUQ = al256c(OFF_WABIN + 2 * SZ_ABIN * 2);
constexpr size_t OFF_WUKV = al256c(OFF_WUQ + 2 * SZ_UQ * 2);
constexpr size_t OFF_WABOUT = al256c(OFF_WUKV + 2 * SZ_UKV * 2);
constexpr size_t OFF_WCDIN = al256c(OFF_WABOUT + 2 * SZ_SQ * 2);
constexpr size_t OFF_WCDOUT = al256c(OFF_WCDIN + 2 * SZ_CDIN * 2);
constexpr size_t OFF_BAR = al256c(OFF_WCDOUT + 2 * SZ_SQ * 2);
constexpr size_t WS_NEED = al256c(OFF_BAR + 16384);

struct Params {
  const float *x, *c, *ctx, *c_ctx, *ada_w, *ada_b, *norm_g;
  const float *q_norm, *kv_norm, *gq_norm, *gk_norm, *sink, *rpb;
  const float *ffn_g, *ffn_u, *ffn_d, *ab_w_in, *w_uq, *w_ukv, *ab_w_out, *cd_w_in, *cd_w_out;
  float* out;
  unsigned char* ws;
};
#define WSF(off) ((float*)(p.ws + (off)))
#define WSH(off) ((u16*)(p.ws + (off)))
#define pX WSF(OFF_X)
#define pMOD WSF(OFF_MOD)
#define pcosH WSF(OFF_COSH)
#define psinH WSF(OFF_SINH)
#define pcosA WSF(OFF_COSA)
#define psinA WSF(OFF_SINA)
#define pH WSH(OFF_H)
#define pY WSH(OFF_Y)
#define pO WSH(OFF_O)
#define pACT WSH(OFF_ACT)
#define pP WSH(OFF_P)
#define pCQN WSH(OFF_CQN)
#define pCKVN WSH(OFF_CKVN)
#define pKR WSH(OFF_KR)
#define pQB WSH(OFF_QB)
#define pKB WSH(OFF_KB)
#define pQA WSH(OFF_QA)
#define pKVA WSH(OFF_KVA)
#define pWgu WSH(OFF_WGU)
#define pWd WSH(OFF_WD)
#define pWabin WSH(OFF_WABIN)
#define pWuq WSH(OFF_WUQ)
#define pWukv WSH(OFF_WUKV)
#define pWabout WSH(OFF_WABOUT)
#define pWcdin WSH(OFF_WCDIN)
#define pWcdout WSH(OFF_WCDOUT)

DI int opq(int x) { asm volatile("" : "+v"(x)); return x; }
#define TIDX opq((int)threadIdx.x)
DI u16 f2bf(float x) { unsigned u = __float_as_uint(x); u += 0x7fffu + ((u >> 16) & 1u); return (u16)(u >> 16); }
DI float bf2f(u16 b) { return __uint_as_float(((unsigned)b) << 16); }
DI unsigned pack2(float a, float b) { return (unsigned)f2bf(a) | ((unsigned)f2bf(b) << 16); }
DI float blo(unsigned u) { return __uint_as_float(u << 16); }
DI float bhi(unsigned u) { return __uint_as_float(u & 0xffff0000u); }
typedef __attribute__((ext_vector_type(2))) float f32x2;
typedef __attribute__((ext_vector_type(2))) __bf16 bf16x2n;
DI unsigned cvt_pk(float a, float b) { f32x2 v = {a, b}; bf16x2n r = __builtin_convertvector(v, bf16x2n); return __builtin_bit_cast(unsigned, r); }
DI float wave_sum(float v) { for (int o = 32; o > 0; o >>= 1) v += __shfl_xor(v, o, 64); return v; }
DI float silu_f(float v) { return v * __builtin_amdgcn_rcpf(1.f + __expf(-v)); }

template <int N> DI u16* selp(u16* const (&a)[N], int i) {
  u16* r = a[0];
#pragma unroll
  for (int k = 1; k < N; ++k) if (i == k) r = a[k];
  return r;
}

DI void prep_mod_task(const Params& p, float* sm, int task) {
  const int tid = TIDX;
  const int l = task / 72, j = task % 72;
  float* sl = sm; float* sc = sm + 1024; float* red = sm + 2048;
  const bool act = tid < 256;
  if (act) for (int i = tid; i < 1024; i += 256) { sl[i] = silu_f(p.c[i]); sc[i] = silu_f(p.c_ctx[i]); }
  __syncthreads();
  const int c4 = tid & 31, kg = (tid >> 5) & 7;
  const float* wp = p.ada_w + ((size_t)l * 1024 + kg * 128) * 9216 + j * 128 + c4 * 4;
  float4 al = {0, 0, 0, 0}, ac = {0, 0, 0, 0};
  if (act) {
#pragma unroll 8
  for (int k = 0; k < 128; ++k) {
    const f32x4 wv_ = __builtin_nontemporal_load((const f32x4*)(wp + (size_t)k * 9216));
    float4 wv = {wv_[0], wv_[1], wv_[2], wv_[3]};
    float a = sl[kg * 128 + k], b = sc[kg * 128 + k];
    al.x += a * wv.x; al.y += a * wv.y; al.z += a * wv.z; al.w += a * wv.w;
    ac.x += b * wv.x; ac.y += b * wv.y; ac.z += b * wv.z; ac.w += b * wv.w;
  }
  *(float4*)(red + (0 * 8 + kg) * 128 + c4 * 4) = al;
  *(float4*)(red + (1 * 8 + kg) * 128 + c4 * 4) = ac;
  }
  __syncthreads();
  if (act) {
    const int which = tid >> 7, col = tid & 127;
    float s = 0;
    for (int g = 0; g < 8; ++g) s += red[(which * 8 + g) * 128 + col];
    s += p.ada_b[l * 9216 + j * 128 + col];
    pMOD[(size_t)(l * 2 + which) * 9216 + j * 128 + col] = s;
  }
  __syncthreads();
}

DI void red_sincos(float ang, float& cs, float& sn) {
  double ad = (double)ang;
  double kq = rint(ad * 0.15915494309189535);
  float r = (float)(ad - kq * 6.283185307179586);
  cs = __cosf(r); sn = __sinf(r);
}

DI void prep_rope_task(const Params& p, int task) {
  const int tidr = TIDX;
  if (tidr >= 256) return;
  const int pos = task * 256 + tidr;
  const float row = (float)(pos >> 6), col = (float)(pos & 63);
  for (int j = 0; j < 16; ++j) {
    float inv = exp2f(-(float)(2 * j) / 32.f * 13.287712379549449f);
    float cs, sn;
    red_sincos(row * inv, cs, sn); pcosH[pos * 32 + j] = cs; psinH[pos * 32 + j] = sn;
    red_sincos(col * inv, cs, sn); pcosH[pos * 32 + 16 + j] = cs; psinH[pos * 32 + 16 + j] = sn;
  }
  for (int j = 0; j < 8; ++j) {
    float inv = exp2f(-(float)(2 * j) / 16.f * 13.287712379549449f);
    float cs, sn;
    red_sincos(row * inv, cs, sn); pcosA[pos * 16 + j] = cs; psinA[pos * 16 + j] = sn;
    red_sincos(col * inv, cs, sn); pcosA[pos * 16 + 8 + j] = cs; psinA[pos * 16 + 8 + j] = sn;
  }
}

DI int layer_ntiles(int l) { return 6 * TR_FFN + ((l & 1) ? 832 : 656); }
DI int layer_tile(int l, int v) {
  if (v < 6 * TR_FFN) return 6 * TR_FFN * l + v;
  return 24 * TR_FFN + (l >> 1) * TR_OTH + ((l & 1) ? 656 : 0) + (v - 6 * TR_FFN);
}
DI void prep_tr_task(const Params& p, float* sm0, int l, int vbase, int vend) {
  const int tidf = TIDX;
  const int tid = tidf & 255;
  const int vv = vbase + (tidf >> 8);
  const bool act = vv < vend;
  const int tile = layer_tile(l, min(vv, vend - 1));
  float* sm = sm0 + (tidf >> 8) * (64 * 65);
  const float* src; u16* dst; int K, N, mode = 0, id;
  if (tile < 24 * TR_FFN) {
    const int mi = tile / TR_FFN; id = tile % TR_FFN;
    const int i = mi / 3, kind = mi % 3;
    if (kind == 0) { src = p.ffn_g + (size_t)i * DM * DFF; dst = pWgu + i * SZ_WGU; K = DM; N = DFF; mode = 1; }
    else if (kind == 1) { src = p.ffn_u + (size_t)i * DM * DFF; dst = pWgu + i * SZ_WGU; K = DM; N = DFF; mode = 2; }
    else { src = p.ffn_d + (size_t)i * DM * DFF; dst = pWd + i * SZ_WD; K = DFF; N = DM; }
  } else {
    const int r2 = tile - 24 * TR_FFN; const int i = r2 / TR_OTH; int r = r2 % TR_OTH;
    if (r < 320) { src = p.ab_w_in + (size_t)i * DM * 1184; dst = pWabin + i * SZ_ABIN; K = DM; N = 1184; id = r; }
    else if (r < 368) { src = p.w_uq + (size_t)i * 256 * 768; dst = pWuq + i * SZ_UQ; K = 256; N = 768; id = r - 320; }
    else if (r < 400) { src = p.w_ukv + (size_t)i * 128 * 1024; dst = pWukv + i * SZ_UKV; K = 128; N = 1024; id = r - 368; }
    else if (r < 656) { src = p.ab_w_out + (size_t)i * DM * DM; dst = pWabout + i * SZ_SQ; K = DM; N = DM; id = r - 400; }
    else if (r < 1232) { src = p.cd_w_in + (size_t)i * DM * 2304; dst = pWcdin + i * SZ_CDIN; K = DM; N = 2304; id = r - 656; }
    else { src = p.cd_w_out + (size_t)i * DM * DM; dst = pWcdout + i * SZ_SQ; K = DM; N = DM; id = r - 1232; }
  }
  const int nkt = K >> 6;
  const int k0 = (id % nkt) * 64, n0 = (id / nkt) * 64;
  if (act) {
    const int cn = (tid & 15) * 4, rk = tid >> 4;
#pragma unroll
    for (int i = 0; i < 4; ++i) {
      const int k = rk + 16 * i;
      float4 v = {0, 0, 0, 0};
      if (n0 + cn < N) { const f32x4 v_ = __builtin_nontemporal_load((const f32x4*)(src + (size_t)(k0 + k) * N + n0 + cn)); v = (float4){v_[0], v_[1], v_[2], v_[3]}; }
      sm[k * 65 + cn + 0] = v.x; sm[k * 65 + cn + 1] = v.y; sm[k * 65 + cn + 2] = v.z; sm[k * 65 + cn + 3] = v.w;
    }
  }
  __syncthreads();
  if (act) {
    const int kc = (tid & 7) * 8;
#pragma unroll
    for (int i = 0; i < 2; ++i) {
      const int nl = (tid >> 3) + 32 * i;
      const int n = n0 + nl;
      int drow = n;
      if (mode == 1) drow = (n >> 4) * 32 + (n & 15);
      else if (mode == 2) drow = (n >> 4) * 32 + 16 + (n & 15);
      uint4 o;
      o.x = pack2(sm[(kc + 0) * 65 + nl], sm[(kc + 1) * 65 + nl]);
      o.y = pack2(sm[(kc + 2) * 65 + nl], sm[(kc + 3) * 65 + nl]);
      o.z = pack2(sm[(kc + 4) * 65 + nl], sm[(kc + 5) * 65 + nl]);
      o.w = pack2(sm[(kc + 6) * 65 + nl], sm[(kc + 7) * 65 + nl]);
      *(uint4*)(dst + (size_t)drow * K + k0 + kc) = o;
    }
  }
  __syncthreads();
}

DI void phase_prep(const Params& p, unsigned char* smem, int bid, int nb) {
  float* sm = (float*)smem;
  const int n_mod = 4 * 72, n_rope = 64;
  for (int task = bid; task < n_mod + n_rope; task += nb) {
    if (task < n_mod) prep_mod_task(p, sm, task);
    else prep_rope_task(p, task - n_mod);
  }
  const int n0 = layer_ntiles(0);
  for (int base = ((bid + nb - (n_mod + n_rope) % nb) % nb) * 2; base < n0; base += nb * 2) prep_tr_task(p, sm, 0, base, n0);
}

DI void tail_convert(const Params& p, unsigned char* smem, int bid, int nb, int l, int s) {
  if (l >= 3) return;
  int v0, v1, first;
  if (s == 0) { v0 = 0; v1 = 1008; first = 88; }
  else if (s == 1) { v0 = 1008; v1 = 3408; first = 16; }
  else if (s == 7) { v0 = 3408; v1 = 4368; first = 16; }
  else if (s == 9) { v0 = 4368; v1 = 5376; first = 88; }
  else return;
  const int nt = layer_ntiles(l + 1);
  if (v1 > nt) v1 = nt;
  if (first >= nb) first = 0;
  if (bid < first) return;
  const int e = bid - first, ne = nb - first;
  for (int base = v0 + 2 * e; base < v1; base += 2 * ne) prep_tr_task(p, (float*)smem, l + 1, base, v1);
}

template <int R>
DI void rowop_load(const Params& p, int lane, int row0, int rstep, bool has_post, bool first,
                   f32x4 (&xq)[R][4], u32x2 (&yq)[R][4]) {
#pragma unroll
  for (int j = 0; j < R; ++j) {
    const int row = row0 + j * rstep;
    const float* xin;
    if (first) xin = (row < N_CTX) ? p.ctx + (size_t)row * DM : p.x + (size_t)(row - N_CTX) * DM;
    else xin = pX + (size_t)row * DM;
#pragma unroll
    for (int i = 0; i < 4; ++i) xq[j][i] = *(const f32x4*)(xin + i * 256 + lane * 4);
    if (has_post) {
#pragma unroll
      for (int i = 0; i < 4; ++i) yq[j][i] = *(const u32x2*)(pY + (size_t)row * DM + i * 256 + lane * 4);
    }
  }
}

template <int R>
DI void rowop_proc(const Params& p, const float* sv, int lane, int row0, int rstep, bool has_post, bool last,
                   float w, bool has_pre, f32x4 (&xq)[R][4], u32x2 (&yq)[R][4]) {
  bool isctx[R];
#pragma unroll
  for (int j = 0; j < R; ++j) isctx[j] = (row0 + j * rstep) < N_CTX;
  if (has_post) {
    float ss[R];
#pragma unroll
    for (int j = 0; j < R; ++j) {
      ss[j] = 0.f;
#pragma unroll
      for (int i = 0; i < 4; ++i) {
        const float y0 = blo(yq[j][i][0]), y1 = bhi(yq[j][i][0]), y2 = blo(yq[j][i][1]), y3 = bhi(yq[j][i][1]);
        ss[j] += y0 * y0 + y1 * y1 + y2 * y2 + y3 * y3;
      }
    }
#pragma unroll
    for (int o = 32; o > 0; o >>= 1)
#pragma unroll
      for (int j = 0; j < R; ++j) ss[j] += __shfl_xor(ss[j], o, 64);
    const float* gp = sv + 2 * 1024;
#pragma unroll
    for (int j = 0; j < R; ++j) {
      const int row = row0 + j * rstep;
      const float rs = rsqrtf(ss[j] * (1.f / DM) + 1e-6f) * w;
      const float* gate = sv + (isctx[j] ? 1024 : 0);
#pragma unroll
      for (int i = 0; i < 4; ++i) {
        const f32x4 gt = *(const f32x4*)(gate + i * 256 + lane * 4);
        const f32x4 gg = *(const f32x4*)(gp + i * 256 + lane * 4);
        xq[j][i][0] += gt[0] * (blo(yq[j][i][0]) * rs * gg[0]);
        xq[j][i][1] += gt[1] * (bhi(yq[j][i][0]) * rs * gg[1]);
        xq[j][i][2] += gt[2] * (blo(yq[j][i][1]) * rs * gg[2]);
        xq[j][i][3] += gt[3] * (bhi(yq[j][i][1]) * rs * gg[3]);
      }
      if (!(last && isctx[j])) {
        float* xo = last ? p.out + (size_t)(row - N_CTX) * DM : pX + (size_t)row * DM;
#pragma unroll
        for (int i = 0; i < 4; ++i) *(f32x4*)(xo + i * 256 + lane * 4) = xq[j][i];
      }
    }
  }
  if (has_pre) {
    float ss[R];
#pragma unroll
    for (int j = 0; j < R; ++j) {
      ss[j] = 0.f;
#pragma unroll
      for (int i = 0; i < 4; ++i) ss[j] += xq[j][i][0] * xq[j][i][0] + xq[j][i][1] * xq[j][i][1] + xq[j][i][2] * xq[j][i][2] + xq[j][i][3] * xq[j][i][3];
    }
#pragma unroll
    for (int o = 32; o > 0; o >>= 1)
#pragma unroll
      for (int j = 0; j < R; ++j) ss[j] += __shfl_xor(ss[j], o, 64);
    const float* gp = sv + 7 * 1024;
#pragma unroll
    for (int j = 0; j < R; ++j) {
      const int row = row0 + j * rstep;
      const float rs = rsqrtf(ss[j] * (1.f / DM) + 1e-6f);
      const float* md = sv + (isctx[j] ? 4 * 1024 : 3 * 1024);
#pragma unroll
      for (int i = 0; i < 4; ++i) {
        const f32x4 sh = *(const f32x4*)(md + i * 256 + lane * 4);
        const f32x4 sc = *(const f32x4*)(md + 2 * 1024 + i * 256 + lane * 4);
        const f32x4 gg = *(const f32x4*)(gp + i * 256 + lane * 4);
        const float h0 = xq[j][i][0] * rs * gg[0] * (1.f + sc[0]) + sh[0];
        const float h1 = xq[j][i][1] * rs * gg[1] * (1.f + sc[1]) + sh[1];
        const float h2 = xq[j][i][2] * rs * gg[2] * (1.f + sc[2]) + sh[2];
        const float h3 = xq[j][i][3] * rs * gg[3] * (1.f + sc[3]) + sh[3];
        u32x2 o = {cvt_pk(h0, h1), cvt_pk(h2, h3)};
        *(u32x2*)(pH + (size_t)row * DM + i * 256 + lane * 4) = o;
      }
    }
  }
}

DI void phase_rowop(const Params& p, unsigned char* smem, int bid, int nb, bool has_post, bool first, bool last,
                    int l_post, int slot_post, float w, bool has_pre, int l_pre, int slot_pre) {
  const int tid = TIDX;
  const int lane = tid & 63, gw = bid * NWAVE + (tid >> 6), nw = nb * NWAVE;
  float* sv = (float*)smem;
  {
    const int v = tid >> 6;
    const float* src;
    if (v == 0) src = pMOD + (size_t)(l_post * 2) * 9216 + (3 * slot_post + 2) * DM;
    else if (v == 1) src = pMOD + (size_t)(l_post * 2 + 1) * 9216 + (3 * slot_post + 2) * DM;
    else if (v == 2) src = p.norm_g + (size_t)(l_post * 6 + 2 * slot_post + 1) * DM;
    else if (v == 3) src = pMOD + (size_t)(l_pre * 2) * 9216 + (3 * slot_pre) * DM;
    else if (v == 4) src = pMOD + (size_t)(l_pre * 2 + 1) * 9216 + (3 * slot_pre) * DM;
    else if (v == 5) src = pMOD + (size_t)(l_pre * 2) * 9216 + (3 * slot_pre + 1) * DM;
    else if (v == 6) src = pMOD + (size_t)(l_pre * 2 + 1) * 9216 + (3 * slot_pre + 1) * DM;
    else src = p.norm_g + (size_t)(l_pre * 6 + 2 * slot_pre) * DM;
    const bool need = (v <= 2) ? has_post : has_pre;
    if (need) {
#pragma unroll
      for (int i = 0; i < 4; ++i) *(float4*)(sv + v * 1024 + i * 256 + lane * 4) = *(const float4*)(src + i * 256 + lane * 4);
    }
  }
  __syncthreads();
  int row = gw;
  if (row + nw < T_TOK) {
    f32x4 xa[2][4], xb[2][4]; u32x2 ya[2][4], yb[2][4];
    rowop_load<2>(p, lane, row, nw, has_post, first, xa, ya);
    for (;;) {
      const int nrow = row + 2 * nw;
      const bool more = nrow + nw < T_TOK;
      if (more) rowop_load<2>(p, lane, nrow, nw, has_post, first, xb, yb);
      rowop_proc<2>(p, sv, lane, row, nw, has_post, last, w, has_pre, xa, ya);
      row = nrow;
      if (!more) break;
#pragma unroll
      for (int j = 0; j < 2; ++j)
#pragma unroll
        for (int i = 0; i < 4; ++i) { xa[j][i] = xb[j][i]; ya[j][i] = yb[j][i]; }
    }
  }
  if (row < T_TOK) {
    f32x4 xs[1][4]; u32x2 ys[1][4];
    rowop_load<1>(p, lane, row, nw, has_post, first, xs, ys);
    rowop_proc<1>(p, sv, lane, row, nw, has_post, last, w, has_pre, xs, ys);
  }
  __syncthreads();
}

constexpr int G_STAGE = (256 + 256) * 64 * 2;
template <int MTW>
DI void gemm_tile(const unsigned char* wsb, unsigned char* smem, const u16* __restrict__ A, int lda, const u16* __restrict__ W, int K,
                  u16* __restrict__ out, int ldo, int epi, int m0, int n0,
                  u32x4 (&ra)[4], u32x4 (&rw)[4], bool pre, bool has_next, int m0n, int n0n) {
  constexpr int BM = 32 * MTW, AI = (MTW >= 2) ? MTW / 2 : 1;
  constexpr int MB = MTW / 2;
  const int tid = TIDX, lane = tid & 63, wv = tid >> 6, wm = wv >> 2, wn = wv & 3;
  const int r = lane & 31, hf = lane >> 5;
  f32x16 acc[2][MB];
#pragma unroll
  for (int a = 0; a < 2; ++a)
#pragma unroll
    for (int b = 0; b < MB; ++b)
#pragma unroll
      for (int i = 0; i < 16; ++i) acc[a][b][i] = 0.f;
  const int c8 = (tid & 7) * 8, r0 = tid >> 3;
  const int c8s = ((tid & 7) ^ ((r0 >> 1) & 7)) * 8;
  int xs[4];
#pragma unroll
  for (int s = 0; s < 4; ++s) xs[s] = ((2 * s + hf) ^ ((r >> 1) & 7)) * 8;
  unsigned ga = (unsigned)((const unsigned char*)A - wsb) + (unsigned)((m0 + r0) * lda + c8) * 2u;
  unsigned gw = (unsigned)((const unsigned char*)W - wsb) + (unsigned)((n0 + r0) * K + c8) * 2u;
  const unsigned sa = (unsigned)lda * 128u, sw = (unsigned)K * 128u;
#define G_LOAD() { _Pragma("unroll") for (int i_ = 0; i_ < AI; ++i_) ra[i_] = *(const u32x4*)(wsb + (ga + i_ * sa)); \
    _Pragma("unroll") for (int i_ = 0; i_ < 4; ++i_) rw[i_] = *(const u32x4*)(wsb + (gw + i_ * sw)); ga += 128u; gw += 128u; }
#define G_STORE(buf) { u16* sA_ = (u16*)(smem + (buf) * G_STAGE); u16* sW_ = sA_ + 256 * 64; \
    _Pragma("unroll") for (int i_ = 0; i_ < AI; ++i_) *(u32x4*)(sA_ + (r0 + 64 * i_) * 64 + c8s) = ra[i_]; \
    _Pragma("unroll") for (int i_ = 0; i_ < 4; ++i_) *(u32x4*)(sW_ + (r0 + 64 * i_) * 64 + c8s) = rw[i_]; }
  const int nk = K >> 6;
  if (pre) { ga += 128u; gw += 128u; } else G_LOAD();
  G_STORE(0);
  if (nk > 1) G_LOAD();
  __syncthreads();
  for (int kt = 0; kt < nk; ++kt) {
    const u16* sA = (const u16*)(smem + (kt & 1) * G_STAGE); const u16* sW = sA + 256 * 64;
    u16* nA = (u16*)(smem + ((kt + 1) & 1) * G_STAGE); u16* nW = nA + 256 * 64;
    const u16* sWr = sW + (wn * 64 + r) * 64;
    const u16* sAr = sA + (wm * (16 * MTW) + r) * 64;
    bf16x8 wf[2][2], xf[2][MB];
#pragma unroll
    for (int nb = 0; nb < 2; ++nb) wf[0][nb] = *(const bf16x8*)(sWr + nb * 32 * 64 + xs[0]);
#pragma unroll
    for (int mb = 0; mb < MB; ++mb) xf[0][mb] = *(const bf16x8*)(sAr + mb * 32 * 64 + xs[0]);
    __builtin_amdgcn_sched_barrier(0);
#pragma unroll
    for (int s = 0; s < 4; ++s) {
      if (s < 3) {
#pragma unroll
        for (int nb = 0; nb < 2; ++nb) wf[(s + 1) & 1][nb] = *(const bf16x8*)(sWr + nb * 32 * 64 + xs[s + 1]);
#pragma unroll
        for (int mb = 0; mb < MB; ++mb) xf[(s + 1) & 1][mb] = *(const bf16x8*)(sAr + mb * 32 * 64 + xs[s + 1]);
      }
      __builtin_amdgcn_sched_barrier(0);
      if (s == 1 && kt + 1 < nk) {
#pragma unroll
        for (int i = 0; i < AI; ++i) *(u32x4*)(nA + (r0 + 64 * i) * 64 + c8s) = ra[i];
#pragma unroll
        for (int i = 0; i < 4; ++i) *(u32x4*)(nW + (r0 + 64 * i) * 64 + c8s) = rw[i];
      }
      if (s == 1 && kt + 2 < nk) G_LOAD();
#pragma unroll
      for (int mb = 0; mb < MB; ++mb)
#pragma unroll
        for (int nb = 0; nb < 2; ++nb)
          acc[nb][mb] = __builtin_amdgcn_mfma_f32_32x32x16_bf16(wf[s & 1][nb], xf[s & 1][mb], acc[nb][mb], 0, 0, 0);
    }
    __syncthreads();
  }
  if (has_next) {
    ga = (unsigned)((const unsigned char*)A - wsb) + (unsigned)((m0n + r0) * lda + c8) * 2u;
    gw = (unsigned)((const unsigned char*)W - wsb) + (unsigned)((n0n + r0) * K + c8) * 2u;
    G_LOAD();
  }
#undef G_LOAD
#undef G_STORE
  {
    unsigned char* ep = smem + G_STAGE + wv * 8192;
    constexpr int ROWS = 16 * MTW;
    if (epi == 0) {
      constexpr int PASSES = (ROWS * 128 > 8192) ? 2 : 1, RP = ROWS / PASSES, MBP = MB / PASSES;
#pragma unroll
      for (int ps_ = 0; ps_ < PASSES; ++ps_) {
#pragma unroll
        for (int mbl = 0; mbl < MBP; ++mbl) {
          const int mb = ps_ * MBP + mbl;
          const int row = mbl * 32 + r;
#pragma unroll
          for (int nb = 0; nb < 2; ++nb)
#pragma unroll
            for (int g4 = 0; g4 < 4; ++g4) {
              const int c8i = nb * 8 + 2 * g4 + hf;
              u32x2 v = {cvt_pk(acc[nb][mb][4 * g4 + 0], acc[nb][mb][4 * g4 + 1]), cvt_pk(acc[nb][mb][4 * g4 + 2], acc[nb][mb][4 * g4 + 3])};
              *(u32x2*)(ep + row * 128 + ((c8i ^ ((row & 7) << 1)) << 3)) = v;
            }
        }
#pragma unroll
        for (int i = 0; i < RP / 8; ++i) {
          const int row = i * 8 + (lane >> 3), c16 = lane & 7;
          const u32x4 v = *(const u32x4*)(ep + row * 128 + ((c16 ^ (row & 7)) << 4));
          *(u32x4*)(out + (size_t)(m0 + wm * ROWS + ps_ * RP + row) * ldo + n0 + wn * 64 + c16 * 8) = v;
        }
      }
    } else {
#pragma unroll
      for (int mb = 0; mb < MB; ++mb) {
        const int row = mb * 32 + r;
#pragma unroll
        for (int nb = 0; nb < 2; ++nb)
#pragma unroll
          for (int gg = 0; gg < 2; ++gg) {
            const int c8i = nb * 4 + 2 * gg + hf;
            const float a0 = silu_f(acc[nb][mb][4 * gg + 0]) * acc[nb][mb][8 + 4 * gg + 0];
            const float a1 = silu_f(acc[nb][mb][4 * gg + 1]) * acc[nb][mb][8 + 4 * gg + 1];
            const float a2 = silu_f(acc[nb][mb][4 * gg + 2]) * acc[nb][mb][8 + 4 * gg + 2];
            const float a3 = silu_f(acc[nb][mb][4 * gg + 3]) * acc[nb][mb][8 + 4 * gg + 3];
            u32x2 v = {cvt_pk(a0, a1), cvt_pk(a2, a3)};
            *(u32x2*)(ep + row * 64 + ((c8i ^ ((row & 3) << 1)) << 3)) = v;
          }
      }
#pragma unroll
      for (int i = 0; i < ROWS / 16; ++i) {
        const int row = i * 16 + (lane >> 2), c16 = lane & 3;
        const u32x4 v = *(const u32x4*)(ep + row * 64 + ((c16 ^ (row & 3)) << 4));
        *(u32x4*)(out + (size_t)(m0 + wm * ROWS + row) * ldo + ((n0 + wn * 64) >> 1) + c16 * 8) = v;
      }
    }
  }
}

struct GemmD { const u16* A; int lda; const u16* W; int K, N; u16* out; int ldo, epi; };

DI void phase_gemm(const unsigned char* wsb, unsigned char* smem, int bid, int nb, const GemmD& g0, const GemmD& g1, bool with_ctx) {
  const int n0t = g0.N >> 8, n1t = g1.N >> 8;
  const int big0 = 64 * n0t, big1 = 64 * n1t, mini0 = with_ctx ? 4 * n0t : 0, mini1 = with_ctx ? 4 * n1t : 0;
  int rem = big0 % nb;
  if (rem * 2 > nb) rem = 0;
  const int full0 = big0 - rem, half0 = 2 * rem;
  const int total = full0 + half0 + big1 + mini0 + mini1;
  u32x4 ra[4], rw[4];
#pragma unroll
  for (int i = 0; i < 4; ++i) { ra[i] = (u32x4){0u, 0u, 0u, 0u}; rw[i] = (u32x4){0u, 0u, 0u, 0u}; }
  bool pre = false;
  for (int tile = bid; tile < total; tile += nb) {
    int id = tile; bool sec = false; int kind = 0;
    if (id < full0) {}
    else if (id < full0 + half0) { id -= full0; kind = 1; }
    else if (id < full0 + half0 + big1) { id -= full0 + half0; sec = true; }
    else if (id < full0 + half0 + big1 + mini0) { id -= full0 + half0 + big1; kind = 2; }
    else { id -= full0 + half0 + big1 + mini0; sec = true; kind = 2; }
    const u16* A = sec ? g1.A : g0.A; const int lda = sec ? g1.lda : g0.lda;
    const u16* W = sec ? g1.W : g0.W; const int K = sec ? g1.K : g0.K;
    u16* out = sec ? g1.out : g0.out; const int ldo = sec ? g1.ldo : g0.ldo; const int epi = sec ? g1.epi : g0.epi;
    if (kind == 0) {
      const int mt = id & 63, nt = id >> 6;
      const int idn = tile + nb; const bool nxt = !sec && idn < full0;
      gemm_tile<8>(wsb, smem, A, lda, W, K, out, ldo, epi, N_CTX + mt * 256, nt * 256, ra, rw, pre, nxt, N_CTX + (idn & 63) * 256, (idn >> 6) * 256);
      pre = nxt;
    }
    else if (kind == 1) {
      const int big = full0 + (id >> 1); const int mt = big & 63, nt = big >> 6;
      gemm_tile<4>(wsb, smem, A, lda, W, K, out, ldo, epi, N_CTX + mt * 256 + (id & 1) * 128, nt * 256, ra, rw, false, false, 0, 0);
    }
    else { const int mt = id & 3, nt = id >> 2; gemm_tile<2>(wsb, smem, A, lda, W, K, out, ldo, epi, mt * 64, nt * 256, ra, rw, false, false, 0, 0); }
  }
}

DI void phase_abprep(const Params& p, int bid, int nb, int li) {
  const int lane = TIDX & 63, wv = TIDX >> 6;
  const float* qn = p.q_norm + li * 256; const float* kvn = p.kv_norm + li * 128;
  const float* gq = p.gq_norm + li * 64; const float* gk = p.gk_norm + li * 64;
  for (int t = bid * NWAVE + wv; t < T_TOK; t += nb * NWAVE) {
    const u16* Pr = pP + (size_t)t * 1280;
    const bool lat = t >= N_CTX; const int pos = t - N_CTX;
    {
      uint2 v = *(const uint2*)(Pr + lane * 4);
      float f0 = blo(v.x), f1 = bhi(v.x), f2 = blo(v.y), f3 = bhi(v.y);
      float ss = wave_sum(f0 * f0 + f1 * f1 + f2 * f2 + f3 * f3);
      float rs = rsqrtf(ss * (1.f / 256) + 1e-6f);
      float4 g = *(const float4*)(qn + lane * 4);
      uint2 o = {pack2(f0 * rs * g.x, f1 * rs * g.y), pack2(f2 * rs * g.z, f3 * rs * g.w)};
      *(uint2*)(pCQN + (size_t)t * 256 + lane * 4) = o;
    }
    {
      unsigned v = *(const unsigned*)(Pr + 256 + lane * 2);
      float f0 = blo(v), f1 = bhi(v);
      float ss = wave_sum(f0 * f0 + f1 * f1);
      float rs = rsqrtf(ss * (1.f / 128) + 1e-6f);
      *(unsigned*)(pCKVN + (size_t)t * 128 + lane * 2) = pack2(f0 * rs * kvn[lane * 2], f1 * rs * kvn[lane * 2 + 1]);
    }
    if (lane < 16) {
      float x1 = bf2f(Pr[384 + lane]), x2 = bf2f(Pr[400 + lane]);
      float o1 = x1, o2 = x2;
      if (lat) { float cs = pcosA[pos * 16 + lane], sn = psinA[pos * 16 + lane]; o1 = x1 * cs - x2 * sn; o2 = x1 * sn + x2 * cs; }
      pKR[(size_t)t * 32 + lane] = f2bf(o1); pKR[(size_t)t * 32 + 16 + lane] = f2bf(o2);
    }
    float cs = 1.f, sn = 0.f;
    if (lat) { cs = pcosH[pos * 32 + (lane & 31)]; sn = psinH[pos * 32 + (lane & 31)]; }
    for (int h = 0; h < 10; ++h) {
      const bool isq = h < 8;
      float xv = bf2f(Pr[(isq ? 416 + h * 64 : 928 + (h - 8) * 64) + lane]);
      float ss = wave_sum(xv * xv);
      float rs = rsqrtf(ss * (1.f / 64) + 1e-6f);
      float y = xv * rs * (isq ? gq[lane] : gk[lane]);
      float pr = __shfl_xor(y, 32, 64);
      float o = (lane < 32) ? (y * cs - pr * sn) : (pr * sn + y * cs);
      if (isq) pQB[(size_t)t * 512 + h * 64 + lane] = f2bf(o);
      else pKB[(size_t)t * 128 + (h - 8) * 64 + lane] = f2bf(o);
    }
  }
}

DI void phase_cdprep(const Params& p, int bid, int nb) {
  const int lane = TIDX & 63, wv = TIDX >> 6;
  for (int t = N_CTX + bid * NWAVE + wv; t < T_TOK; t += nb * NWAVE) {
    u16* Pr = pP + (size_t)t * 2304;
    const int pos = t - N_CTX;
    const int j = lane & 31;
    const float cs = pcosH[pos * 32 + j], sn = psinH[pos * 32 + j];
    for (int it = 0; it < 5; ++it) {
      const int h = it * 2 + (lane >> 5);
      u16* hp = Pr + h * 64;
      float x1 = bf2f(hp[j]), x2 = bf2f(hp[32 + j]);
      hp[j] = f2bf(x1 * cs - x2 * sn); hp[32 + j] = f2bf(x1 * sn + x2 * cs);
    }
  }
}

struct HG {
  const u16* q; int ldq;
  const u16* k1; int ldk1, k1hs;
  const u16* k2; int ldk2;
  const u16* v; int ldv, vhs;
  int group, mode, ropeq, ocol;
  float scale; const float* sink; const float* rpb;
};

template <int DQK>
DI void attn_naive_item(const Params& p, const HG& g, int t, int h) {
  float q[DQK];
  const u16* qp = g.q + (size_t)t * g.ldq + h * DQK;
#pragma unroll
  for (int c = 0; c < DQK / 8; ++c) {
    uint4 v = *(const uint4*)(qp + c * 8);
    q[c * 8 + 0] = blo(v.x); q[c * 8 + 1] = bhi(v.x); q[c * 8 + 2] = blo(v.y); q[c * 8 + 3] = bhi(v.y);
    q[c * 8 + 4] = blo(v.z); q[c * 8 + 5] = bhi(v.z); q[c * 8 + 6] = blo(v.w); q[c * 8 + 7] = bhi(v.w);
  }
  const bool lat = t >= N_CTX; const int pos = t - N_CTX;
  if (DQK == 96) {
    if (g.ropeq && lat) {
#pragma unroll
      for (int j = 0; j < 16; ++j) {
        float cs = pcosA[pos * 16 + j], sn = psinA[pos * 16 + j];
        float x1 = q[64 + j], x2 = q[80 + j];
        q[64 + j] = x1 * cs - x2 * sn; q[80 + j] = x1 * sn + x2 * cs;
      }
    }
  }
  float o[64];
#pragma unroll
  for (int d = 0; d < 64; ++d) o[d] = 0.f;
  float m = -3.0e38f, l = 0.f;
  const int kvh = h / g.group;
  const int row = pos >> 6, col = pos & 63;
  const int r0 = min(max(row - 4, 0), 248), c0 = min(max(col - 8, 0), 48);
  int ncand = N_CTX;
  if (lat) ncand = (g.mode == 0) ? T_TOK : (g.mode == 1 ? N_CTX + 257 : N_CTX + 128);
  for (int ci = 0; ci < ncand; ++ci) {
    int key = ci; float bias = 0.f; bool valid = true;
    if (ci >= N_CTX) {
      if (g.mode == 1) { int kp = pos - 128 + (ci - N_CTX); valid = (kp >= 0) && (kp < S_LAT); key = N_CTX + kp; }
      else if (g.mode == 2) {
        int n = ci - N_CTX; int kr = r0 + (n >> 4), kc = c0 + (n & 15);
        key = N_CTX + kr * 64 + kc;
        bias = g.rpb[h * 465 + (kr - row + 7) * 31 + (kc - col + 15)];
      }
    }
    if (!valid) continue;
    const u16* kp1 = g.k1 + (size_t)key * g.ldk1 + kvh * g.k1hs;
    float s = 0.f;
#pragma unroll
    for (int c = 0; c < 8; ++c) {
      uint4 v = *(const uint4*)(kp1 + c * 8);
      s += q[c * 8 + 0] * blo(v.x) + q[c * 8 + 1] * bhi(v.x) + q[c * 8 + 2] * blo(v.y) + q[c * 8 + 3] * bhi(v.y)
         + q[c * 8 + 4] * blo(v.z) + q[c * 8 + 5] * bhi(v.z) + q[c * 8 + 6] * blo(v.w) + q[c * 8 + 7] * bhi(v.w);
    }
    if (DQK == 96) {
      const u16* kp2 = g.k2 + (size_t)key * g.ldk2;
#pragma unroll
      for (int c = 0; c < 4; ++c) {
        uint4 v = *(const uint4*)(kp2 + c * 8);
        s += q[64 + c * 8 + 0] * blo(v.x) + q[64 + c * 8 + 1] * bhi(v.x) + q[64 + c * 8 + 2] * blo(v.y) + q[64 + c * 8 + 3] * bhi(v.y)
           + q[64 + c * 8 + 4] * blo(v.z) + q[64 + c * 8 + 5] * bhi(v.z) + q[64 + c * 8 + 6] * blo(v.w) + q[64 + c * 8 + 7] * bhi(v.w);
      }
    }
    s = s * g.scale + bias;
    const float mn = fmaxf(m, s);
    const float a = __expf(m - mn), pe = __expf(s - mn);
    l = l * a + pe; m = mn;
    const u16* vp = g.v + (size_t)key * g.ldv + kvh * g.vhs;
#pragma unroll
    for (int c = 0; c < 8; ++c) {
      uint4 v = *(const uint4*)(vp + c * 8);
      o[c * 8 + 0] = o[c * 8 + 0] * a + pe * blo(v.x); o[c * 8 + 1] = o[c * 8 + 1] * a + pe * bhi(v.x);
      o[c * 8 + 2] = o[c * 8 + 2] * a + pe * blo(v.y); o[c * 8 + 3] = o[c * 8 + 3] * a + pe * bhi(v.y);
      o[c * 8 + 4] = o[c * 8 + 4] * a + pe * blo(v.z); o[c * 8 + 5] = o[c * 8 + 5] * a + pe * bhi(v.z);
      o[c * 8 + 6] = o[c * 8 + 6] * a + pe * blo(v.w); o[c * 8 + 7] = o[c * 8 + 7] * a + pe * bhi(v.w);
    }
  }
  if (g.sink) {
    const float s = g.sink[h];
    const float mn = fmaxf(m, s);
    const float a = __expf(m - mn), pe = __expf(s - mn);
    l = l * a + pe;
#pragma unroll
    for (int d = 0; d < 64; ++d) o[d] *= a;
  }
  const float il = 1.f / l;
  u16* op = pO + (size_t)t * DM + g.ocol + h * 64;
#pragma unroll
  for (int c = 0; c < 8; ++c) {
    uint4 v;
    v.x = pack2(o[c * 8 + 0] * il, o[c * 8 + 1] * il); v.y = pack2(o[c * 8 + 2] * il, o[c * 8 + 3] * il);
    v.z = pack2(o[c * 8 + 4] * il, o[c * 8 + 5] * il); v.w = pack2(o[c * 8 + 6] * il, o[c * 8 + 7] * il);
    *(uint4*)(op + c * 8) = v;
  }
}

DI void make_hg(const Params& p, int l, HG& ga, HG& gb) {
  const int li = l >> 1;
  if ((l & 1) == 0) {
    ga.q = pQA; ga.ldq = 768; ga.k1 = pKVA; ga.ldk1 = 1024; ga.k1hs = 128; ga.k2 = pKR; ga.ldk2 = 32;
    ga.v = pKVA + 64; ga.ldv = 1024; ga.vhs = 128; ga.group = 1; ga.mode = 0; ga.ropeq = 1; ga.ocol = 0;
    ga.scale = 0.10206207261596575f; ga.sink = nullptr; ga.rpb = nullptr;
    gb.q = pQB; gb.ldq = 512; gb.k1 = pKB; gb.ldk1 = 128; gb.k1hs = 64; gb.k2 = nullptr; gb.ldk2 = 0;
    gb.v = pP + 1056; gb.ldv = 1280; gb.vhs = 64; gb.group = 4; gb.mode = 0; gb.ropeq = 0; gb.ocol = 512;
    gb.scale = 0.125f; gb.sink = nullptr; gb.rpb = nullptr;
  } else {
    ga.q = pP; ga.ldq = 2304; ga.k1 = pP + 512; ga.ldk1 = 2304; ga.k1hs = 64; ga.k2 = nullptr; ga.ldk2 = 0;
    ga.v = pP + 640; ga.ldv = 2304; ga.vhs = 64; ga.group = 4; ga.mode = 1; ga.ropeq = 0; ga.ocol = 0;
    ga.scale = 0.125f; ga.sink = p.sink + li * 8; ga.rpb = nullptr;
    gb.q = pP + 768; gb.ldq = 2304; gb.k1 = pP + 1280; gb.ldk1 = 2304; gb.k1hs = 64; gb.k2 = nullptr; gb.ldk2 = 0;
    gb.v = pP + 1792; gb.ldv = 2304; gb.vhs = 64; gb.group = 1; gb.mode = 2; gb.ropeq = 0; gb.ocol = 512;
    gb.scale = 0.125f; gb.sink = nullptr; gb.rpb = p.rpb + li * 8 * 465;
  }
}

DI void phase_attn_naive(const Params& p, int bid, int nb, int l) {
  HG ga, gb; make_hg(p, l, ga, gb);
  const int nchunks = 16 * (T_TOK / 256);
  const int t0 = (l == 3) ? 1 : 0;
  for (int ch = bid; ch < nchunks; ch += nb) {
    const int hh = ch % 16, tc = ch / 16;
    if (tc < t0) continue;
    const int t = tc * 256 + TIDX;
    if (hh < 8) {
      if ((l & 1) == 0) attn_naive_item<96>(p, ga, t, hh);
      else attn_naive_item<64>(p, ga, t, hh);
    } else attn_naive_item<64>(p, gb, t, hh - 8);
  }
}


DI int crow(int i, int hf) { return (i & 3) + 8 * (i >> 2) + 4 * hf; }
DI float fexp2(float x) { return __builtin_amdgcn_exp2f(x); }

template <int DQK>
DI void attn_fast_item(const Params& p, unsigned char* smem, const HG& g, int qt, int h, int tid) {
  constexpr int KST = DQK + 8, NKK = DQK / 16, CPR = DQK / 8, KCH = (64 * CPR + NTHR - 1) / NTHR;
  constexpr int VOFF = 64 * KST * 2;
  constexpr int STAGE = VOFF + 64 * 68 * 2;
  const int lane = tid & 63, wv = tid >> 6, r = lane & 31, hf = lane >> 5;
  const int t = qt * 256 + wv * 32 + r;
  const bool lat = qt >= 1;
  const int qpos = t - N_CTX;
  const int kvh = h / g.group;
  const int mode = g.mode;
  const float sc = g.scale * 1.4426950408889634f;
  bf16x8 qf[NKK];
  {
    const u16* qp = g.q + (size_t)t * g.ldq + h * DQK + hf * 8;
#pragma unroll
    for (int kk = 0; kk < NKK; ++kk) qf[kk] = *(const bf16x8*)(qp + kk * 16);
    if (DQK == 96) {
      if (g.ropeq && lat) {
        bf16x8 a = qf[NKK - 2], b = qf[NKK - 1];
#pragma unroll
        for (int i = 0; i < 8; ++i) {
          const float cs = pcosA[qpos * 16 + 8 * hf + i], sn = psinA[qpos * 16 + 8 * hf + i];
          const float x1 = bf2f((u16)a[i]), x2 = bf2f((u16)b[i]);
          a[i] = (short)f2bf(x1 * cs - x2 * sn); b[i] = (short)f2bf(x1 * sn + x2 * cs);
        }
        qf[NKK - 2] = a; qf[NKK - 1] = b;
      }
    }
#pragma unroll
    for (int kk = 0; kk < NKK; ++kk) {
      u32x4 w = __builtin_bit_cast(u32x4, qf[kk]);
#pragma unroll
      for (int i = 0; i < 4; ++i) w[i] = cvt_pk(blo(w[i]) * sc, bhi(w[i]) * sc);
      qf[kk] = __builtin_bit_cast(bf16x8, w);
    }
  }
  int ntiles = 4, lat_tok0 = N_CTX;
  if (lat) {
    if (mode == 0) ntiles = T_TOK / 64;
    else if (mode == 1) {
      const int s0 = (qt - 1) * 256; const int lo = max(0, s0 - 128), hi = min(S_LAT, s0 + 384);
      ntiles = 4 + ((hi - lo) >> 6); lat_tok0 = N_CTX + lo;
    } else {
      const int rr = 4 * (qt - 1); const int rlo = min(max(rr - 4, 0), 248), rhi = min(max(rr - 1, 0), 248) + 7;
      ntiles = 4 + (rhi - rlo + 1); lat_tok0 = N_CTX + rlo * 64;
    }
  }
  const bool masked_mode = lat && (mode != 0);
  const int qrow = qpos >> 6, qcol = qpos & 63;
  const int r0q = min(max(qrow - 4, 0), 248), c0q = min(max(qcol - 8, 0), 48);
  unsigned koff[KCH], kstr[KCH]; int kdst[KCH];
  const unsigned k1b = (unsigned)((const unsigned char*)g.k1 - p.ws), k2b = (unsigned)((const unsigned char*)g.k2 - p.ws);
#pragma unroll
  for (int i = 0; i < KCH; ++i) {
    const int q = min(tid + NTHR * i, 64 * CPR - 1); const int row = q / CPR, cc = q % CPR;
    if (DQK == 64 || cc < 8) { koff[i] = k1b + (unsigned)(row * g.ldk1 + kvh * g.k1hs + cc * 8) * 2u; kstr[i] = (unsigned)g.ldk1 * 2u; }
    else { koff[i] = k2b + (unsigned)(row * g.ldk2 + (cc - 8) * 8) * 2u; kstr[i] = (unsigned)g.ldk2 * 2u; }
    kdst[i] = (row * KST + cc * 8) * 2;
  }
  const int kp2 = tid & 31, vc = (tid >> 5) & 7;
  const bool vact = tid < 256;
  bool kact[KCH];
#pragma unroll
  for (int i = 0; i < KCH; ++i) kact[i] = (tid + NTHR * i) < 64 * CPR;
  const unsigned voff = (unsigned)((const unsigned char*)g.v - p.ws) + (unsigned)((2 * kp2) * g.ldv + kvh * g.vhs + vc * 8) * 2u;
  const unsigned vstr = (unsigned)g.ldv * 2u;
  const int vdst = VOFF + ((8 * vc) * 68 + 2 * kp2) * 2;
  const int kread = (r * KST + 8 * hf) * 2;
  const int vread = VOFF + (r * 68 + 4 * hf) * 2;

  u32x4 kreg[KCH], vreg0 = {0u, 0u, 0u, 0u}, vreg1 = {0u, 0u, 0u, 0u};
#pragma unroll
  for (int i = 0; i < KCH; ++i) kreg[i] = (u32x4){0u, 0u, 0u, 0u};
  auto tile_tok = [&](int i) { return (i < 4) ? 64 * i : lat_tok0 + 64 * (i - 4); };
#define ATT_LOAD(tok) { _Pragma("unroll") for (int i_ = 0; i_ < KCH; ++i_) if (kact[i_]) kreg[i_] = *(const u32x4*)(p.ws + (koff[i_] + (unsigned)(tok) * kstr[i_])); \
    if (vact) { vreg0 = *(const u32x4*)(p.ws + (voff + (unsigned)(tok) * vstr)); vreg1 = *(const u32x4*)(p.ws + (voff + (unsigned)(tok) * vstr + vstr)); } }
#define ATT_STORE(bufoff) { unsigned char* sb_ = smem + (bufoff); \
    _Pragma("unroll") for (int i_ = 0; i_ < KCH; ++i_) if (kact[i_]) *(u32x4*)(sb_ + kdst[i_]) = kreg[i_]; \
    if (vact) { _Pragma("unroll") for (int i_ = 0; i_ < 4; ++i_) { \
      *(unsigned*)(sb_ + vdst + (2 * i_) * 136) = __builtin_amdgcn_perm(vreg1[i_], vreg0[i_], 0x05040100u); \
      *(unsigned*)(sb_ + vdst + (2 * i_ + 1) * 136) = __builtin_amdgcn_perm(vreg1[i_], vreg0[i_], 0x07060302u); } } }

  f32x16 O0, O1, NEGM;
#pragma unroll
  for (int i = 0; i < 16; ++i) { O0[i] = 0.f; O1[i] = 0.f; NEGM[i] = 0.f; }
  float l = 0.f;

  ATT_LOAD(0);
  ATT_STORE(0);
  __syncthreads();
  for (int it = 0; it < ntiles; ++it) {
    const int tok = tile_tok(it);
    const bool more = it + 1 < ntiles;
    if (more) { const int ntok = tile_tok(it + 1); ATT_LOAD(ntok); }
    const unsigned char* sb = smem + (it & 1) * STAGE;
    bool wave_active = true;
    if (masked_mode && it >= 4) {
      const int q0 = (qt - 1) * 256 + __builtin_amdgcn_readfirstlane(wv) * 32;
      const int kt0u = tok - N_CTX;
      if (mode == 1) wave_active = (kt0u <= q0 + 31 + 128) && (kt0u + 63 >= q0 - 128);
      else { const int r0w = min(max((q0 >> 6) - 4, 0), 248); const int kru = kt0u >> 6; wave_active = (kru >= r0w) && (kru < r0w + 8); }
    }
    if (wave_active) {
    auto compute_S = [&](f32x16& S0, f32x16& S1) {
      bf16x8 kf0[NKK], kf1[NKK];
#pragma unroll
      for (int kk = 0; kk < 2; ++kk) {
        kf0[kk] = *(const bf16x8*)(sb + kread + kk * 32);
        kf1[kk] = *(const bf16x8*)(sb + kread + 32 * KST * 2 + kk * 32);
      }
      __builtin_amdgcn_sched_barrier(0);
      S0 = NEGM; S1 = NEGM;
#pragma unroll
      for (int kk = 0; kk < NKK; ++kk) {
        S0 = __builtin_amdgcn_mfma_f32_32x32x16_bf16(kf0[kk], qf[kk], S0, 0, 0, 0);
        S1 = __builtin_amdgcn_mfma_f32_32x32x16_bf16(kf1[kk], qf[kk], S1, 0, 0, 0);
        if (kk + 2 < NKK) {
          kf0[kk + 2] = *(const bf16x8*)(sb + kread + (kk + 2) * 32);
          kf1[kk + 2] = *(const bf16x8*)(sb + kread + 32 * KST * 2 + (kk + 2) * 32);
        }
        __builtin_amdgcn_sched_barrier(0);
      }
      if (masked_mode && it >= 4) {
        const int kt0 = tok - N_CTX;
        if (mode == 1) {
#pragma unroll
          for (int i = 0; i < 16; ++i) {
            const int k0p = kt0 + crow(i, hf), k1p = k0p + 32;
            int d0 = qpos - k0p; d0 = d0 < 0 ? -d0 : d0; int d1 = qpos - k1p; d1 = d1 < 0 ? -d1 : d1;
            S0[i] = (d0 <= 128) ? S0[i] : -1.0e30f;
            S1[i] = (d1 <= 128) ? S1[i] : -1.0e30f;
          }
        } else {
          const int kr = kt0 >> 6;
          const bool vrow = (kr >= r0q) && (kr < r0q + 8);
          const float* rp = g.rpb + h * 465 + (kr - qrow + 7) * 31 + (15 - qcol);
#pragma unroll
          for (int i = 0; i < 16; ++i) {
            const int kc0 = crow(i, hf), kc1 = kc0 + 32;
            const bool v0 = vrow && (kc0 >= c0q) && (kc0 < c0q + 16);
            const bool v1 = vrow && (kc1 >= c0q) && (kc1 < c0q + 16);
            float b0 = 0.f, b1 = 0.f;
            if (v0) b0 = rp[kc0];
            if (v1) b1 = rp[kc1];
            S0[i] = v0 ? S0[i] + b0 * 1.4426950408889634f : -1.0e30f;
            S1[i] = v1 ? S1[i] + b1 * 1.4426950408889634f : -1.0e30f;
          }
        }
      }
    };
    f32x16 S0, S1;
    compute_S(S0, S1);
    u32x2 vfa[8], vfb[8];
#pragma unroll
    for (int j = 0; j < 4; ++j) {
      vfa[j] = *(const u32x2*)(sb + vread + j * 16);
      vfb[j] = *(const u32x2*)(sb + vread + 32 * 136 + j * 16);
    }
    __builtin_amdgcn_sched_barrier(0);
    float ps = 0.f;
#pragma unroll
    for (int i = 0; i < 16; ++i) {
      S0[i] = fexp2(S0[i]); S1[i] = fexp2(S1[i]);
      ps += S0[i]; asm volatile("" : "+v"(ps));
      ps += S1[i]; asm volatile("" : "+v"(ps));
    }
    if (it == 0 || __builtin_amdgcn_ballot_w64(!(ps < 1.0e30f)) != 0ull) {
      compute_S(S0, S1);
      float mx = __builtin_amdgcn_fmed3f(S0[0], S1[0], __builtin_inff());
#pragma unroll
      for (int i = 1; i < 16; ++i) { mx = __builtin_amdgcn_fmed3f(mx, S0[i], __builtin_inff()); mx = __builtin_amdgcn_fmed3f(mx, S1[i], __builtin_inff()); }
      mx = __builtin_amdgcn_fmed3f(mx, __shfl_xor(mx, 32, 64), __builtin_inff());
      const float dl = (it == 0) ? mx : (mx > 0.f ? mx : 0.f);
#pragma unroll
      for (int i = 0; i < 16; ++i) NEGM[i] -= dl;
      if (it > 0) {
        const float a = fexp2(-dl);
        l *= a;
#pragma unroll
        for (int i = 0; i < 16; ++i) { O0[i] *= a; O1[i] *= a; }
      }
      ps = 0.f;
#pragma unroll
      for (int i = 0; i < 16; ++i) { S0[i] = fexp2(S0[i] - dl); S1[i] = fexp2(S1[i] - dl); ps += S0[i] + S1[i]; }
    }
    l += ps;
    __builtin_amdgcn_sched_barrier(0);
#pragma unroll
    for (int kb = 0; kb < 2; ++kb) {
#pragma unroll
      for (int s2 = 0; s2 < 2; ++s2) {
        u32x4 pk;
        if (kb == 0) { pk[0] = cvt_pk(S0[8 * s2 + 0], S0[8 * s2 + 1]); pk[1] = cvt_pk(S0[8 * s2 + 2], S0[8 * s2 + 3]); pk[2] = cvt_pk(S0[8 * s2 + 4], S0[8 * s2 + 5]); pk[3] = cvt_pk(S0[8 * s2 + 6], S0[8 * s2 + 7]); }
        else { pk[0] = cvt_pk(S1[8 * s2 + 0], S1[8 * s2 + 1]); pk[1] = cvt_pk(S1[8 * s2 + 2], S1[8 * s2 + 3]); pk[2] = cvt_pk(S1[8 * s2 + 4], S1[8 * s2 + 5]); pk[3] = cvt_pk(S1[8 * s2 + 6], S1[8 * s2 + 7]); }
        const bf16x8 pf = __builtin_bit_cast(bf16x8, pk);
        const int jj = 4 * kb + 2 * s2;
        u32x4 va, vb;
        va[0] = vfa[jj][0]; va[1] = vfa[jj][1]; va[2] = vfa[jj + 1][0]; va[3] = vfa[jj + 1][1];
        vb[0] = vfb[jj][0]; vb[1] = vfb[jj][1]; vb[2] = vfb[jj + 1][0]; vb[3] = vfb[jj + 1][1];
        O0 = __builtin_amdgcn_mfma_f32_32x32x16_bf16(__builtin_bit_cast(bf16x8, va), pf, O0, 0, 0, 0);
        O1 = __builtin_amdgcn_mfma_f32_32x32x16_bf16(__builtin_bit_cast(bf16x8, vb), pf, O1, 0, 0, 0);
        if (jj + 4 < 8) {
          vfa[jj + 4] = *(const u32x2*)(sb + vread + (jj + 4) * 16); vfa[jj + 5] = *(const u32x2*)(sb + vread + (jj + 5) * 16);
          vfb[jj + 4] = *(const u32x2*)(sb + vread + 32 * 136 + (jj + 4) * 16); vfb[jj + 5] = *(const u32x2*)(sb + vread + 32 * 136 + (jj + 5) * 16);
        }
        __builtin_amdgcn_sched_barrier(0);
      }
    }
    }
    if (more) ATT_STORE(((it + 1) & 1) * STAGE);
    __syncthreads();
  }
  l += __shfl_xor(l, 32, 64);
  if (g.sink) {
    const float rel = g.sink[h] * 1.4426950408889634f + NEGM[0];
    const float dl = rel > 0.f ? rel : 0.f;
    const float a2 = fexp2(-dl);
    l = l * a2 + fexp2(rel - dl);
#pragma unroll
    for (int i = 0; i < 16; ++i) { O0[i] *= a2; O1[i] *= a2; }
  }
  const float il = 1.f / l;
  u16* op = pO + (size_t)t * DM + g.ocol + h * 64 + 4 * hf;
#pragma unroll
  for (int g4 = 0; g4 < 4; ++g4) {
    u32x2 v0 = {cvt_pk(O0[4 * g4 + 0] * il, O0[4 * g4 + 1] * il), cvt_pk(O0[4 * g4 + 2] * il, O0[4 * g4 + 3] * il)};
    u32x2 v1 = {cvt_pk(O1[4 * g4 + 0] * il, O1[4 * g4 + 1] * il), cvt_pk(O1[4 * g4 + 2] * il, O1[4 * g4 + 3] * il)};
    *(u32x2*)(op + 8 * g4) = v0;
    *(u32x2*)(op + 32 + 8 * g4) = v1;
  }
#undef ATT_LOAD
#undef ATT_STORE
}

DI void phase_attn_fast(const Params& p, unsigned char* smem, int bid, int nb, int l) {
  HG ga, gb; make_hg(p, l, ga, gb);
  const int tid = TIDX;
  const int nitems = (l == 3) ? 1024 : 1040;
  for (int it = bid; it < nitems; it += nb) {
    int h16, qt;
    if (it < 1024) { const int b = it & 255, j = it >> 8; h16 = ((b & 15) + 8 * (j & 1)) & 15; qt = 1 + (b >> 4) + 16 * j; }
    else { h16 = it - 1024; qt = 0; }
    if (h16 < 8) {
      if ((l & 1) == 0) attn_fast_item<96>(p, smem, ga, qt, h16, tid);
      else attn_fast_item<64>(p, smem, ga, qt, h16, tid);
    } else attn_fast_item<64>(p, smem, gb, qt, h16 - 8, tid);
  }
}

#define XB_TMO      128
#define XB_XCNT(j)  (256  + 64 * (j))
#define XB_XSUB(j)  (1280 + 64 * (j))
#define XB_XGEN(j)  (2304 + 64 * (j))
#define XB_TOP      3328
#define XB_TOPGEN   3392
#define XCD_BAR_WORDS 3456
#define XB_SPIN_CAP (1u << 18)
#define LAS __attribute__((address_space(3)))
DI unsigned xb_ld(unsigned* p) { return __hip_atomic_load(p, __ATOMIC_RELAXED, __HIP_MEMORY_SCOPE_AGENT); }
DI unsigned xb_add(unsigned* p, unsigned v) { return __hip_atomic_fetch_add(p, v, __ATOMIC_RELAXED, __HIP_MEMORY_SCOPE_AGENT); }
DI unsigned xb_xcc_id() { return (unsigned)__builtin_amdgcn_s_getreg((3 << 11) | 20) & 0xFu; }
#define XB_SPIN(cond, bar) do { unsigned _sp = 0; while (cond) { __builtin_amdgcn_s_sleep(1); \
    if ((++_sp & 255u) == 0u) { if (xb_ld(&(bar)[XB_TMO])) break; if (_sp > XB_SPIN_CAP) { atomicAdd(&(bar)[XB_TMO], 1u); break; } } } } while (0)
struct XcdBarrier { unsigned* bar; unsigned x; volatile LAS unsigned* st; };
DI XcdBarrier xcd_barrier_post(unsigned* bar, volatile LAS unsigned* st) {
  XcdBarrier b; b.bar = bar; b.x = xb_xcc_id(); b.st = st;
  if (threadIdx.x == 0) (void)xb_add(&bar[XB_XCNT(b.x)], 1u);
  return b;
}
DI void xcd_barrier_complete(unsigned* bar, unsigned x, unsigned& nloc, unsigned& nx) {
  const unsigned G = gridDim.x * gridDim.y * gridDim.z;
  unsigned sum, cnt, mine, sp = 0u;
  for (;;) {
    sum = 0u; cnt = 0u; mine = 0u;
#pragma unroll
    for (unsigned j = 0; j < 16; ++j) { const unsigned c = xb_ld(&bar[XB_XCNT(j)]); sum += c; cnt += (c > 0u) ? 1u : 0u; mine = (j == x) ? c : mine; }
    if (sum == G) break;
    __builtin_amdgcn_s_sleep(1);
    if ((++sp & 255u) == 0u) { if (xb_ld(&bar[XB_TMO])) break; if (sp > XB_SPIN_CAP) { atomicAdd(&bar[XB_TMO], 1u); break; } }
  }
  nloc = mine > 0u ? mine : 1u; nx = cnt > 0u ? cnt : 1u;
}
DI void xcd_barrier(const XcdBarrier& b) {
  asm volatile("s_waitcnt vmcnt(0)" ::: "memory");
  __syncthreads();
  if (threadIdx.x == 0) {
    unsigned* bar = b.bar;
    __builtin_amdgcn_s_waitcnt(0);
    unsigned nloc = b.st[0], nx = b.st[1];
    if (nloc == 0u) { xcd_barrier_complete(bar, b.x, nloc, nx); b.st[0] = nloc; b.st[1] = nx; }
    const unsigned old = xb_add(&bar[XB_XSUB(b.x)], 1u);
    const unsigned gen = old / nloc;
    if (old + 1u == (gen + 1u) * nloc) {
      __builtin_amdgcn_fence(__ATOMIC_RELEASE, "agent");
      asm volatile("s_waitcnt vmcnt(0)" ::: "memory");
      const unsigned og = xb_add(&bar[XB_TOP], 1u);
      const unsigned tg = og / nx;
      if (og + 1u == (tg + 1u) * nx) xb_add(&bar[XB_TOPGEN], 1u);
      else XB_SPIN(xb_ld(&bar[XB_TOPGEN]) == tg, bar);
      __builtin_amdgcn_fence(__ATOMIC_ACQUIRE, "agent");
      xb_add(&bar[XB_XGEN(b.x)], 1u);
      asm volatile("s_waitcnt vmcnt(0)" ::: "memory");
    } else {
      XB_SPIN(xb_ld(&bar[XB_XGEN(b.x)]) == gen, bar);
      __builtin_amdgcn_fence(__ATOMIC_ACQUIRE, "agent");
      asm volatile("s_waitcnt vmcnt(0)" ::: "memory");
    }
  }
  __syncthreads();
}

__global__ void __launch_bounds__(NTHR, 2) mk(Params p, int lo, int hi) {
  __shared__ __attribute__((aligned(16))) unsigned char smem[SMEM_BYTES];
  cg::grid_group grid = cg::this_grid();
  const int bid = blockIdx.x, nb = gridDim.x;
#if !MULTI
  __shared__ uint4 xb_words;
  if (threadIdx.x == 0) xb_words = make_uint4(0u, 0u, 0u, 0u);
  __syncthreads();
  XcdBarrier xb = xcd_barrier_post((unsigned*)(p.ws + OFF_BAR), (volatile LAS unsigned*)&xb_words);
#endif
  for (int phv = lo; phv < hi && phv < NPH; ++phv) {
    const int ph = __builtin_amdgcn_readfirstlane(phv);
    bool did = true;
    if (ph == 0) { for (int rep = 0; rep < REP_PREP; ++rep) phase_prep(p, smem, bid, nb); }
    else if (ph == 1) phase_rowop(p, smem, bid, nb, false, true, false, 0, 0, 0.f, true, 0, 0);
    else {
      const int q = ph - 2, l = q / 12, s = q % 12, li = l >> 1;
      const bool ab = (l & 1) == 0;
      if (s == 2 || s == 8 || s == 11) {
        const int slot = (s == 2) ? 0 : (s == 8 ? 1 : 2);
        const float w = (s == 8) ? 1.0f : 0.5f;
        const bool last = (l == 3 && s == 11);
        const bool first = (l == 0 && s == 2);
        const int lpre = (s == 11) ? l + 1 : l;
        const int spre = (s == 11) ? 0 : slot + 1;
        phase_rowop(p, smem, bid, nb, true, first, last, l, slot, w, !last, lpre, spre);
      } else if (s == 4) {
        if (ab) { for (int rep = 0; rep < REP_MIXPREP; ++rep) phase_abprep(p, bid, nb, li); } else phase_cdprep(p, bid, nb);
      } else if (s == 6) {
        for (int rep = 0; rep < REP_ATTN; ++rep) phase_attn_fast(p, smem, bid, nb, l);
      } else if (s == 5 && !ab) {
        did = false;
      } else {
        GemmD g0, g1;
        g1.A = nullptr; g1.lda = 0; g1.W = nullptr; g1.K = 64; g1.N = 0; g1.out = nullptr; g1.ldo = 0; g1.epi = 0;
        if (s == 0 || s == 9) { g0.A = pH; g0.lda = DM; g0.W = pWgu + (size_t)(l * 2 + (s == 9)) * SZ_WGU; g0.K = DM; g0.N = 2 * DFF; g0.out = pACT; g0.ldo = DFF; g0.epi = 1; }
        else if (s == 1 || s == 10) { g0.A = pACT; g0.lda = DFF; g0.W = pWd + (size_t)(l * 2 + (s == 10)) * SZ_WD; g0.K = DFF; g0.N = DM; g0.out = pY; g0.ldo = DM; g0.epi = 0; }
        else if (s == 3) {
          g0.A = pH; g0.lda = DM; g0.K = DM; g0.out = pP; g0.epi = 0;
          if (ab) { g0.W = pWabin + li * SZ_ABIN; g0.N = 1280; g0.ldo = 1280; } else { g0.W = pWcdin + li * SZ_CDIN; g0.N = 2304; g0.ldo = 2304; }
        } else if (s == 5) {
          g0.A = pCQN; g0.lda = 256; g0.W = pWuq + li * SZ_UQ; g0.K = 256; g0.N = 768; g0.out = pQA; g0.ldo = 768; g0.epi = 0;
          g1.A = pCKVN; g1.lda = 128; g1.W = pWukv + li * SZ_UKV; g1.K = 128; g1.N = 1024; g1.out = pKVA; g1.ldo = 1024; g1.epi = 0;
        } else {
          g0.A = pO; g0.lda = DM; g0.W = ab ? pWabout + li * SZ_SQ : pWcdout + li * SZ_SQ; g0.K = DM; g0.N = DM; g0.out = pY; g0.ldo = DM; g0.epi = 0;
        }
        for (int rep = 0; rep < (((REP_GEMM_MASK >> s) & 1) ? REP_GEMM : 1); ++rep) phase_gemm(p.ws, smem, bid, nb, g0, g1, !(l == 3 && s >= 7));
        tail_convert(p, smem, bid, nb, l, s);
      }
    }
    #if MULTI
    if (did && ph + 1 < hi) grid.sync();
#else
    if (did && ph + 1 < hi) { if (ph == 0) grid.sync(); else { for (int rep = 0; rep < REP_SYNC; ++rep) xcd_barrier(xb); } }
#endif
  }
}

static inline size_t al256(size_t x) { return (x + 255) & ~(size_t)255; }

extern "C" void kernel_launch(void* const* d_in, const int* in_sizes, int n_in, void* d_out, int out_size,
                              void* d_ws, size_t ws_size, hipStream_t stream) {
  Params p;
  memset(&p, 0, sizeof(p));
  const float* x = (const float*)d_in[0];
  p.x = x; p.c = (const float*)d_in[1]; p.ctx = (const float*)d_in[2]; p.c_ctx = (const float*)d_in[3];
  p.ada_w = (const float*)d_in[4]; p.ada_b = (const float*)d_in[5]; p.norm_g = (const float*)d_in[6];
  const float* ffn_g = (const float*)d_in[7]; const float* ffn_u = (const float*)d_in[8]; const float* ffn_d = (const float*)d_in[9];
  const float* ab_w_in = (const float*)d_in[10]; p.q_norm = (const float*)d_in[11]; const float* w_uq = (const float*)d_in[12];
  p.kv_norm = (const float*)d_in[13]; const float* w_ukv = (const float*)d_in[14];
  p.gq_norm = (const float*)d_in[15]; p.gk_norm = (const float*)d_in[16];
  const float* ab_w_out = (const float*)d_in[17]; const float* cd_w_in = (const float*)d_in[18];
  p.sink = (const float*)d_in[19]; p.rpb = (const float*)d_in[20]; const float* cd_w_out = (const float*)d_in[21];
  p.out = (float*)d_out;

  p.ws = (unsigned char*)d_ws;
  p.ffn_g = ffn_g; p.ffn_u = ffn_u; p.ffn_d = ffn_d; p.ab_w_in = ab_w_in; p.w_uq = w_uq; p.w_ukv = w_ukv;
  p.ab_w_out = ab_w_out; p.cd_w_in = cd_w_in; p.cd_w_out = cd_w_out;
  const size_t off = WS_NEED;
  if (off > ws_size) { fprintf(stderr, "workspace too small: need %zu have %zu\n", off, ws_size); return; }

  static int grid_blocks = 0;
  if (!grid_blocks) {
    int dev = 0, cus = 0, per_cu = 0;
    hipGetDevice(&dev);
    hipDeviceGetAttribute(&cus, hipDeviceAttributeMultiprocessorCount, dev);
    hipOccupancyMaxActiveBlocksPerMultiprocessor(&per_cu, mk, NTHR, 0);
    if (per_cu > 1) per_cu = 1;
    if (per_cu < 1) per_cu = 1;
    grid_blocks = cus * per_cu;
  }
#if MULTI
  for (int ph = 0; ph < NPH; ++ph) {
    if (ph >= 2 && ((ph - 2) % 12) == 5 && (((ph - 2) / 12) & 1)) continue;
    hipLaunchKernelGGL(mk, dim3(grid_blocks), dim3(NTHR), 0, stream, p, ph, ph + 1);
  }
#else
  int lo = 0, hi = NPH;
  void* args[] = {&p, &lo, &hi};
  hipMemsetAsync((unsigned char*)d_ws + OFF_BAR, 0, 16384, stream);
  hipError_t e = hipLaunchCooperativeKernel((void*)mk, dim3(grid_blocks), dim3(NTHR), args, 0, stream);
  if (e != hipSuccess) fprintf(stderr, "cooperative launch failed: %s (grid %d)\n", hipGetErrorString(e), grid_blocks);
#endif
}
```

```cpp
#include <hip/hip_runtime.h>
#include <hip/hip_cooperative_groups.h>
#include <stdint.h>
#include <string.h>
#include <stdio.h>
namespace cg = cooperative_groups;

#ifndef MULTI
#define MULTI 0
#endif
#ifndef REP_ATTN
#define REP_ATTN 1
#endif
#ifndef REP_GEMM
#define REP_GEMM 1
#endif
#ifndef REP_PREP
#define REP_PREP 1
#endif
#ifndef REP_SYNC
#define REP_SYNC 1
#endif
#ifndef REP_MIXPREP
#define REP_MIXPREP 1
#endif
#ifndef REP_GEMM_MASK
#define REP_GEMM_MASK 0xFFF
#endif
#ifndef FAST_ATTN
#define FAST_ATTN 1
#endif

typedef unsigned short u16;
typedef __attribute__((ext_vector_type(8))) short bf16x8;
typedef __attribute__((ext_vector_type(4))) float f32x4;
typedef __attribute__((ext_vector_type(16))) float f32x16;
typedef __attribute__((ext_vector_type(4))) unsigned u32x4;
typedef __attribute__((ext_vector_type(2))) unsigned u32x2;
#define DI __device__ __forceinline__

constexpr int T_TOK = 16640, S_LAT = 16384, N_CTX = 256, DM = 1024, DFF = 2816;
constexpr int NTHR = 512, NWAVE = 8;
constexpr int SMEM_BYTES = 2 * (256 + 256) * 64 * 2;
constexpr int NMATS = 36;
constexpr int NPH = 2 + 4 * 12;


constexpr size_t al256c(size_t x) { return (x + 255) & ~(size_t)255; }
constexpr size_t SZ_WGU = (size_t)2 * DFF * DM, SZ_WD = (size_t)DM * DFF, SZ_ABIN = (size_t)1280 * DM, SZ_UQ = 768 * 256,
                 SZ_UKV = 1024 * 128, SZ_SQ = (size_t)DM * DM, SZ_CDIN = (size_t)2304 * DM;
constexpr int TR_FFN = 704, TR_OTH = 320 + 48 + 32 + 256 + 576 + 256, TR_TOTAL = 24 * TR_FFN + 2 * TR_OTH;
constexpr size_t OFF_X = 0;
constexpr size_t OFF_MOD = al256c(OFF_X + (size_t)T_TOK * DM * 4);
constexpr size_t OFF_COSH = al256c(OFF_MOD + (size_t)8 * 9216 * 4);
constexpr size_t OFF_SINH = al256c(OFF_COSH + (size_t)S_LAT * 32 * 4);
constexpr size_t OFF_COSA = al256c(OFF_SINH + (size_t)S_LAT * 32 * 4);
constexpr size_t OFF_SINA = al256c(OFF_COSA + (size_t)S_LAT * 16 * 4);
constexpr size_t OFF_H = al256c(OFF_SINA + (size_t)S_LAT * 16 * 4);
constexpr size_t OFF_Y = al256c(OFF_H + (size_t)T_TOK * DM * 2);
constexpr size_t OFF_O = al256c(OFF_Y + (size_t)T_TOK * DM * 2);
constexpr size_t OFF_U = al256c(OFF_O + (size_t)T_TOK * DM * 2);
constexpr size_t OFF_ACT = OFF_U;
constexpr size_t OFF_P = OFF_U;
constexpr size_t OFF_CQN = al256c(OFF_P + (size_t)T_TOK * 2304 * 2);
constexpr size_t OFF_CKVN = al256c(OFF_CQN + (size_t)T_TOK * 256 * 2);
constexpr size_t OFF_KR = al256c(OFF_CKVN + (size_t)T_TOK * 128 * 2);
constexpr size_t OFF_QB = al256c(OFF_KR + (size_t)T_TOK * 32 * 2);
constexpr size_t OFF_KB = al256c(OFF_QB + (size_t)T_TOK * 512 * 2);
constexpr size_t OFF_QA = al256c(OFF_KB + (size_t)T_TOK * 128 * 2);
constexpr size_t OFF_KVA = al256c(OFF_QA + (size_t)T_TOK * 768 * 2);
constexpr size_t OFF_UEND = al256c(OFF_KVA + (size_t)T_TOK * 1024 * 2);
static_assert(OFF_UEND >= OFF_ACT + (size_t)T_TOK * DFF * 2, "union");
constexpr size_t OFF_WGU = OFF_UEND;
constexpr size_t OFF_WD = al256c(OFF_WGU + 8 * SZ_WGU * 2);
constexpr size_t OFF_WABIN = al256c(OFF_WD + 8 * SZ_WD * 2);
constexpr size_t OFF_WUQ = al256c(OFF_WABIN + 2 * SZ_ABIN * 2);
constexpr size_t OFF_WUKV = al256c(OFF_WUQ + 2 * SZ_UQ * 2);
constexpr size_t OFF_WABOUT = al256c(OFF_WUKV + 2 * SZ_UKV * 2);
constexpr size_t OFF_WCDIN = al256c(OFF_WABOUT + 2 * SZ_SQ * 2);
constexpr size_t OFF_WCDOUT = al256c(OFF_WCDIN + 2 * SZ_CDIN * 2);
constexpr size_t OFF_BAR = al256c(OFF_WCDOUT + 2 * SZ_SQ * 2);
constexpr size_t WS_NEED = al256c(OFF_BAR + 16384);

struct Params {
  const float *x, *c, *ctx, *c_ctx, *ada_w, *ada_b, *norm_g;
  const float *q_norm, *kv_norm, *gq_norm, *gk_norm, *sink, *rpb;
  const float *ffn_g, *ffn_u, *ffn_d, *ab_w_in, *w_uq, *w_ukv, *ab_w_out, *cd_w_in, *cd_w_out;
  float* out;
  unsigned char* ws;
};
#define WSF(off) ((float*)(p.ws + (off)))
#define WSH(off) ((u16*)(p.ws + (off)))
#define pX WSF(OFF_X)
#define pMOD WSF(OFF_MOD)
#define pcosH WSF(OFF_COSH)
#define psinH WSF(OFF_SINH)
#define pcosA WSF(OFF_COSA)
#define psinA WSF(OFF_SINA)
#define pH WSH(OFF_H)
#define pY WSH(OFF_Y)
#define pO WSH(OFF_O)
#define pACT WSH(OFF_ACT)
#define pP WSH(OFF_P)
#define pCQN WSH(OFF_CQN)
#define pCKVN WSH(OFF_CKVN)
#define pKR WSH(OFF_KR)
#define pQB WSH(OFF_QB)
#define pKB WSH(OFF_KB)
#define pQA WSH(OFF_QA)
#define pKVA WSH(OFF_KVA)
#define pWgu WSH(OFF_WGU)
#define pWd WSH(OFF_WD)
#define pWabin WSH(OFF_WABIN)
#define pWuq WSH(OFF_WUQ)
#define pWukv WSH(OFF_WUKV)
#define pWabout WSH(OFF_WABOUT)
#define pWcdin WSH(OFF_WCDIN)
#define pWcdout WSH(OFF_WCDOUT)

DI int opq(int x) { asm volatile("" : "+v"(x)); return x; }
#define TIDX opq((int)threadIdx.x)
DI u16 f2bf(float x) { unsigned u = __float_as_uint(x); u += 0x7fffu + ((u >> 16) & 1u); return (u16)(u >> 16); }
DI float bf2f(u16 b) { return __uint_as_float(((unsigned)b) << 16); }
DI unsigned pack2(float a, float b) { return (unsigned)f2bf(a) | ((unsigned)f2bf(b) << 16); }
DI float blo(unsigned u) { return __uint_as_float(u << 16); }
DI float bhi(unsigned u) { return __uint_as_float(u & 0xffff0000u); }
typedef __attribute__((ext_vector_type(2))) float f32x2;
typedef __attribute__((ext_vector_type(2))) __bf16 bf16x2n;
DI unsigned cvt_pk(float a, float b) { f32x2 v = {a, b}; bf16x2n r = __builtin_convertvector(v, bf16x2n); return __builtin_bit_cast(unsigned, r); }
DI float wave_sum(float v) { for (int o = 32; o > 0; o >>= 1) v += __shfl_xor(v, o, 64); return v; }
DI float silu_f(float v) { return v * __builtin_amdgcn_rcpf(1.f + __expf(-v)); }

template <int N> DI u16* selp(u16* const (&a)[N], int i) {
  u16* r = a[0];
#pragma unroll
  for (int k = 1; k < N; ++k) if (i == k) r = a[k];
  return r;
}

DI void prep_mod_task(const Params& p, float* sm, int task) {
  const int tid = TIDX;
  const int l = task / 72, j = task % 72;
  float* sl = sm; float* sc = sm + 1024; float* red = sm + 2048;
  const bool act = tid < 256;
  if (act) for (int i = tid; i < 1024; i += 256) { sl[i] = silu_f(p.c[i]); sc[i] = silu_f(p.c_ctx[i]); }
  __syncthreads();
  const int c4 = tid & 31, kg = (tid >> 5) & 7;
  const float* wp = p.ada_w + ((size_t)l * 1024 + kg * 128) * 9216 + j * 128 + c4 * 4;
  float4 al = {0, 0, 0, 0}, ac = {0, 0, 0, 0};
  if (act) {
#pragma unroll 8
  for (int k = 0; k < 128; ++k) {
    const f32x4 wv_ = __builtin_nontemporal_load((const f32x4*)(wp + (size_t)k * 9216));
    float4 wv = {wv_[0], wv_[1], wv_[2], wv_[3]};
    float a = sl[kg * 128 + k], b = sc[kg * 128 + k];
    al.x += a * wv.x; al.y += a * wv.y; al.z += a * wv.z; al.w += a * wv.w;
    ac.x += b * wv.x; ac.y += b * wv.y; ac.z += b * wv.z; ac.w += b * wv.w;
  }
  *(float4*)(red + (0 * 8 + kg) * 128 + c4 * 4) = al;
  *(float4*)(red + (1 * 8 + kg) * 128 + c4 * 4) = ac;
  }
  __syncthreads();
  if (act) {
    const int which = tid >> 7, col = tid & 127;
    float s = 0;
    for (int g = 0; g < 8; ++g) s += red[(which * 8 + g) * 128 + col];
    s += p.ada_b[l * 9216 + j * 128 + col];
    pMOD[(size_t)(l * 2 + which) * 9216 + j * 128 + col] = s;
  }
  __syncthreads();
}

DI void red_sincos(float ang, float& cs, float& sn) {
  double ad = (double)ang;
  double kq = rint(ad * 0.15915494309189535);
  float r = (float)(ad - kq * 6.283185307179586);
  cs = __cosf(r); sn = __sinf(r);
}

DI void prep_rope_task(const Params& p, int task) {
  const int tidr = TIDX;
  if (tidr >= 256) return;
  const int pos = task * 256 + tidr;
  const float row = (float)(pos >> 6), col = (float)(pos & 63);
  for (int j = 0; j < 16; ++j) {
    float inv = exp2f(-(float)(2 * j) / 32.f * 13.287712379549449f);
    float cs, sn;
    red_sincos(row * inv, cs, sn); pcosH[pos * 32 + j] = cs; psinH[pos * 32 + j] = sn;
    red_sincos(col * inv, cs, sn); pcosH[pos * 32 + 16 + j] = cs; psinH[pos * 32 + 16 + j] = sn;
  }
  for (int j = 0; j < 8; ++j) {
    float inv = exp2f(-(float)(2 * j) / 16.f * 13.287712379549449f);
    float cs, sn;
    red_sincos(row * inv, cs, sn); pcosA[pos * 16 + j] = cs; psinA[pos * 16 + j] = sn;
    red_sincos(col * inv, cs, sn); pcosA[pos * 16 + 8 + j] = cs; psinA[pos * 16 + 8 + j] = sn;
  }
}

DI int layer_ntiles(int l) { return 6 * TR_FFN + ((l & 1) ? 832 : 656); }
DI int layer_tile(int l, int v) {
  if (v < 6 * TR_FFN) return 6 * TR_FFN * l + v;
  return 24 * TR_FFN + (l >> 1) * TR_OTH + ((l & 1) ? 656 : 0) + (v - 6 * TR_FFN);
}
DI void prep_tr_task(const Params& p, float* sm0, int l, int vbase, int vend) {
  const int tidf = TIDX;
  const int tid = tidf & 255;
  const int vv = vbase + (tidf >> 8);
  const bool act = vv < vend;
  const int tile = layer_tile(l, min(vv, vend - 1));
  float* sm = sm0 + (tidf >> 8) * (64 * 65);
  const float* src; u16* dst; int K, N, mode = 0, id;
  if (tile < 24 * TR_FFN) {
    const int mi = tile / TR_FFN; id = tile % TR_FFN;
    const int i = mi / 3, kind = mi % 3;
    if (kind == 0) { src = p.ffn_g + (size_t)i * DM * DFF; dst = pWgu + i * SZ_WGU; K = DM; N = DFF; mode = 1; }
    else if (kind == 1) { src = p.ffn_u + (size_t)i * DM * DFF; dst = pWgu + i * SZ_WGU; K = DM; N = DFF; mode = 2; }
    else { src = p.ffn_d + (size_t)i * DM * DFF; dst = pWd + i * SZ_WD; K = DFF; N = DM; }
  } else {
    const int r2 = tile - 24 * TR_FFN; const int i = r2 / TR_OTH; int r = r2 % TR_OTH;
    if (r < 320) { src = p.ab_w_in + (size_t)i * DM * 1184; dst = pWabin + i * SZ_ABIN; K = DM; N = 1184; id = r; }
    else if (r < 368) { src = p.w_uq + (size_t)i * 256 * 768; dst = pWuq + i * SZ_UQ; K = 256; N = 768; id = r - 320; }
    else if (r < 400) { src = p.w_ukv + (size_t)i * 128 * 1024; dst = pWukv + i * SZ_UKV; K = 128; N = 1024; id = r - 368; }
    else if (r < 656) { src = p.ab_w_out + (size_t)i * DM * DM; dst = pWabout + i * SZ_SQ; K = DM; N = DM; id = r - 400; }
    else if (r < 1232) { src = p.cd_w_in + (size_t)i * DM * 2304; dst = pWcdin + i * SZ_CDIN; K = DM; N = 2304; id = r - 656; }
    else { src = p.cd_w_out + (size_t)i * DM * DM; dst = pWcdout + i * SZ_SQ; K = DM; N = DM; id = r - 1232; }
  }
  const int nkt = K >> 6;
  const int k0 = (id % nkt) * 64, n0 = (id / nkt) * 64;
  if (act) {
    const int cn = (tid & 15) * 4, rk = tid >> 4;
#pragma unroll
    for (int i = 0; i < 4; ++i) {
      const int k = rk + 16 * i;
      float4 v = {0, 0, 0, 0};
      if (n0 + cn < N) { const f32x4 v_ = __builtin_nontemporal_load((const f32x4*)(src + (size_t)(k0 + k) * N + n0 + cn)); v = (float4){v_[0], v_[1], v_[2], v_[3]}; }
      sm[k * 65 + cn + 0] = v.x; sm[k * 65 + cn + 1] = v.y; sm[k * 65 + cn + 2] = v.z; sm[k * 65 + cn + 3] = v.w;
    }
  }
  __syncthreads();
  if (act) {
    const int kc = (tid & 7) * 8;
#pragma unroll
    for (int i = 0; i < 2; ++i) {
      const int nl = (tid >> 3) + 32 * i;
      const int n = n0 + nl;
      int drow = n;
      if (mode == 1) drow = (n >> 4) * 32 + (n & 15);
      else if (mode == 2) drow = (n >> 4) * 32 + 16 + (n & 15);
      uint4 o;
      o.x = pack2(sm[(kc + 0) * 65 + nl], sm[(kc + 1) * 65 + nl]);
      o.y = pack2(sm[(kc + 2) * 65 + nl], sm[(kc + 3) * 65 + nl]);
      o.z = pack2(sm[(kc + 4) * 65 + nl], sm[(kc + 5) * 65 + nl]);
      o.w = pack2(sm[(kc + 6) * 65 + nl], sm[(kc + 7) * 65 + nl]);
      *(uint4*)(dst + (size_t)drow * K + k0 + kc) = o;
    }
  }
  __syncthreads();
}

DI void phase_prep(const Params& p, unsigned char* smem, int bid, int nb) {
  float* sm = (float*)smem;
  const int n_mod = 4 * 72, n_rope = 64;
  for (int task = bid; task < n_mod + n_rope; task += nb) {
    if (task < n_mod) prep_mod_task(p, sm, task);
    else prep_rope_task(p, task - n_mod);
  }
  const int n0 = layer_ntiles(0);
  for (int base = ((bid + nb - (n_mod + n_rope) % nb) % nb) * 2; base < n0; base += nb * 2) prep_tr_task(p, sm, 0, base, n0);
}

DI void tail_convert(const Params& p, unsigned char* smem, int bid, int nb, int l, int s) {
  if (l >= 3) return;
  int v0, v1, first;
  if (s == 0) { v0 = 0; v1 = 1008; first = 88; }
  else if (s == 1) { v0 = 1008; v1 = 3408; first = 16; }
  else if (s == 7) { v0 = 3408; v1 = 4368; first = 16; }
  else if (s == 9) { v0 = 4368; v1 = 5376; first = 88; }
  else return;
  const int nt = layer_ntiles(l + 1);
  if (v1 > nt) v1 = nt;
  if (first >= nb) first = 0;
  if (bid < first) return;
  const int e = bid - first, ne = nb - first;
  for (int base = v0 + 2 * e; base < v1; base += 2 * ne) prep_tr_task(p, (float*)smem, l + 1, base, v1);
}

template <int R>
DI void rowop_load(const Params& p, int lane, int row0, int rstep, bool has_post, bool first,
                   f32x4 (&xq)[R][4], u32x2 (&yq)[R][4]) {
#pragma unroll
  for (int j = 0; j < R; ++j) {
    const int row = row0 + j * rstep;
    const float* xin;
    if (first) xin = (row < N_CTX) ? p.ctx + (size_t)row * DM : p.x + (size_t)(row - N_CTX) * DM;
    else xin = pX + (size_t)row * DM;
#pragma unroll
    for (int i = 0; i < 4; ++i) xq[j][i] = *(const f32x4*)(xin + i * 256 + lane * 4);
    if (has_post) {
#pragma unroll
      for (int i = 0; i < 4; ++i) yq[j][i] = *(const u32x2*)(pY + (size_t)row * DM + i * 256 + lane * 4);
    }
  }
}

template <int R>
DI void rowop_proc(const Params& p, const float* sv, int lane, int row0, int rstep, bool has_post, bool last,
                   float w, bool has_pre, f32x4 (&xq)[R][4], u32x2 (&yq)[R][4]) {
  bool isctx[R];
#pragma unroll
  for (int j = 0; j < R; ++j) isctx[j] = (row0 + j * rstep) < N_CTX;
  if (has_post) {
    float ss[R];
#pragma unroll
    for (int j = 0; j < R; ++j) {
      ss[j] = 0.f;
#pragma unroll
      for (int i = 0; i < 4; ++i) {
        const float y0 = blo(yq[j][i][0]), y1 = bhi(yq[j][i][0]), y2 = blo(yq[j][i][1]), y3 = bhi(yq[j][i][1]);
        ss[j] += y0 * y0 + y1 * y1 + y2 * y2 + y3 * y3;
      }
    }
#pragma unroll
    for (int o = 32; o > 0; o >>= 1)
#pragma unroll
      for (int j = 0; j < R; ++j) ss[j] += __shfl_xor(ss[j], o, 64);
    const float* gp = sv + 2 * 1024;
#pragma unroll
    for (int j = 0; j < R; ++j) {
      const int row = row0 + j * rstep;
      const float rs = rsqrtf(ss[j] * (1.f / DM) + 1e-6f) * w;
      const float* gate = sv + (isctx[j] ? 1024 : 0);
#pragma unroll
      for (int i = 0; i < 4; ++i) {
        const f32x4 gt = *(const f32x4*)(gate + i * 256 + lane * 4);
        const f32x4 gg = *(const f32x4*)(gp + i * 256 + lane * 4);
        xq[j][i][0] += gt[0] * (blo(yq[j][i][0]) * rs * gg[0]);
        xq[j][i][1] += gt[1] * (bhi(yq[j][i][0]) * rs * gg[1]);
        xq[j][i][2] += gt[2] * (blo(yq[j][i][1]) * rs * gg[2]);
        xq[j][i][3] += gt[3] * (bhi(yq[j][i][1]) * rs * gg[3]);
      }
      if (!(last && isctx[j])) {
        float* xo = last ? p.out + (size_t)(row - N_CTX) * DM : pX + (size_t)row * DM;
#pragma unroll
        for (int i = 0; i < 4; ++i) *(f32x4*)(xo + i * 256 + lane * 4) = xq[j][i];
      }
    }
  }
  if (has_pre) {
    float ss[R];
#pragma unroll
    for (int j = 0; j < R; ++j) {
      ss[j] = 0.f;
#pragma unroll
      for (int i = 0; i < 4; ++i) ss[j] += xq[j][i][0] * xq[j][i][0] + xq[j][i][1] * xq[j][i][1] + xq[j][i][2] * xq[j][i][2] + xq[j][i][3] * xq[j][i][3];
    }
#pragma unroll
    for (int o = 32; o > 0; o >>= 1)
#pragma unroll
      for (int j = 0; j < R; ++j) ss[j] += __shfl_xor(ss[j], o, 64);
    const float* gp = sv + 7 * 1024;
#pragma unroll
    for (int j = 0; j < R; ++j) {
      const int row = row0 + j * rstep;
      const float rs = rsqrtf(ss[j] * (1.f / DM) + 1e-6f);
      const float* md = sv + (isctx[j] ? 4 * 1024 : 3 * 1024);
#pragma unroll
      for (int i = 0; i < 4; ++i) {
        const f32x4 sh = *(const f32x4*)(md + i * 256 + lane * 4);
        const f32x4 sc = *(const f32x4*)(md + 2 * 1024 + i * 256 + lane * 4);
        const f32x4 gg = *(const f32x4*)(gp + i * 256 + lane * 4);
        const float h0 = xq[j][i][0] * rs * gg[0] * (1.f + sc[0]) + sh[0];
        const float h1 = xq[j][i][1] * rs * gg[1] * (1.f + sc[1]) + sh[1];
        const float h2 = xq[j][i][2] * rs * gg[2] * (1.f + sc[2]) + sh[2];
        const float h3 = xq[j][i][3] * rs * gg[3] * (1.f + sc[3]) + sh[3];
        u32x2 o = {cvt_pk(h0, h1), cvt_pk(h2, h3)};
        *(u32x2*)(pH + (size_t)row * DM + i * 256 + lane * 4) = o;
      }
    }
  }
}

DI void phase_rowop(const Params& p, unsigned char* smem, int bid, int nb, bool has_post, bool first, bool last,
                    int l_post, int slot_post, float w, bool has_pre, int l_pre, int slot_pre) {
  const int tid = TIDX;
  const int lane = tid & 63, gw = bid * NWAVE + (tid >> 6), nw = nb * NWAVE;
  float* sv = (float*)smem;
  {
    const int v = tid >> 6;
    const float* src;
    if (v == 0) src = pMOD + (size_t)(l_post * 2) * 9216 + (3 * slot_post + 2) * DM;
    else if (v == 1) src = pMOD + (size_t)(l_post * 2 + 1) * 9216 + (3 * slot_post + 2) * DM;
    else if (v == 2) src = p.norm_g + (size_t)(l_post * 6 + 2 * slot_post + 1) * DM;
    else if (v == 3) src = pMOD + (size_t)(l_pre * 2) * 9216 + (3 * slot_pre) * DM;
    else if (v == 4) src = pMOD + (size_t)(l_pre * 2 + 1) * 9216 + (3 * slot_pre) * DM;
    else if (v == 5) src = pMOD + (size_t)(l_pre * 2) * 9216 + (3 * slot_pre + 1) * DM;
    else if (v == 6) src = pMOD + (size_t)(l_pre * 2 + 1) * 9216 + (3 * slot_pre + 1) * DM;
    else src = p.norm_g + (size_t)(l_pre * 6 + 2 * slot_pre) * DM;
    const bool need = (v <= 2) ? has_post : has_pre;
    if (need) {
#pragma unroll
      for (int i = 0; i < 4; ++i) *(float4*)(sv + v * 1024 + i * 256 + lane * 4) = *(const float4*)(src + i * 256 + lane * 4);
    }
  }
  __syncthreads();
  int row = gw;
  if (row + nw < T_TOK) {
    f32x4 xa[2][4], xb[2][4]; u32x2 ya[2][4], yb[2][4];
    rowop_load<2>(p, lane, row, nw, has_post, first, xa, ya);
    for (;;) {
      const int nrow = row + 2 * nw;
      const bool more = nrow + nw < T_TOK;
      if (more) rowop_load<2>(p, lane, nrow, nw, has_post, first, xb, yb);
      rowop_proc<2>(p, sv, lane, row, nw, has_post, last, w, has_pre, xa, ya);
      row = nrow;
      if (!more) break;
#pragma unroll
      for (int j = 0; j < 2; ++j)
#pragma unroll
        for (int i = 0; i < 4; ++i) { xa[j][i] = xb[j][i]; ya[j][i] = yb[j][i]; }
    }
  }
  if (row < T_TOK) {
    f32x4 xs[1][4]; u32x2 ys[1][4];
    rowop_load<1>(p, lane, row, nw, has_post, first, xs, ys);
    rowop_proc<1>(p, sv, lane, row, nw, has_post, last, w, has_pre, xs, ys);
  }
  __syncthreads();
}

constexpr int G_STAGE = (256 + 256) * 64 * 2;
template <int MTW>
DI void gemm_tile(const unsigned char* wsb, unsigned char* smem, const u16* __restrict__ A, int lda, const u16* __restrict__ W, int K,
                  u16* __restrict__ out, int ldo, int epi, int m0, int n0,
                  u32x4 (&ra)[4], u32x4 (&rw)[4], bool pre, bool has_next, int m0n, int n0n) {
  constexpr int BM = 32 * MTW, AI = (MTW >= 2) ? MTW / 2 : 1;
  constexpr int MB = MTW / 2;
  const int tid = TIDX, lane = tid & 63, wv = tid >> 6, wm = wv >> 2, wn = wv & 3;
  const int r = lane & 31, hf = lane >> 5;
  f32x16 acc[2][MB];
#pragma unroll
  for (int a = 0; a < 2; ++a)
#pragma unroll
    for (int b = 0; b < MB; ++b)
#pragma unroll
      for (int i = 0; i < 16; ++i) acc[a][b][i] = 0.f;
  const int c8 = (tid & 7) * 8, r0 = tid >> 3;
  const int c8s = ((tid & 7) ^ ((r0 >> 1) & 7)) * 8;
  int xs[4];
#pragma unroll
  for (int s = 0; s < 4; ++s) xs[s] = ((2 * s + hf) ^ ((r >> 1) & 7)) * 8;
  unsigned ga = (unsigned)((const unsigned char*)A - wsb) + (unsigned)((m0 + r0) * lda + c8) * 2u;
  unsigned gw = (unsigned)((const unsigned char*)W - wsb) + (unsigned)((n0 + r0) * K + c8) * 2u;
  const unsigned sa = (unsigned)lda * 128u, sw = (unsigned)K * 128u;
#define G_LOAD() { _Pragma("unroll") for (int i_ = 0; i_ < AI; ++i_) ra[i_] = *(const u32x4*)(wsb + (ga + i_ * sa)); \
    _Pragma("unroll") for (int i_ = 0; i_ < 4; ++i_) rw[i_] = *(const u32x4*)(wsb + (gw + i_ * sw)); ga += 128u; gw += 128u; }
#define G_STORE(buf) { u16* sA_ = (u16*)(smem + (buf) * G_STAGE); u16* sW_ = sA_ + 256 * 64; \
    _Pragma("unroll") for (int i_ = 0; i_ < AI; ++i_) *(u32x4*)(sA_ + (r0 + 64 * i_) * 64 + c8s) = ra[i_]; \
    _Pragma("unroll") for (int i_ = 0; i_ < 4; ++i_) *(u32x4*)(sW_ + (r0 + 64 * i_) * 64 + c8s) = rw[i_]; }
  const int nk = K >> 6;
  if (pre) { ga += 128u; gw += 128u; } else G_LOAD();
  G_STORE(0);
  if (nk > 1) G_LOAD();
  __syncthreads();
  for (int kt = 0; kt < nk; ++kt) {
    const u16* sA = (const u16*)(smem + (kt & 1) * G_STAGE); const u16* sW = sA + 256 * 64;
    u16* nA = (u16*)(smem + ((kt + 1) & 1) * G_STAGE); u16* nW = nA + 256 * 64;
    const u16* sWr = sW + (wn * 64 + r) * 64;
    const u16* sAr = sA + (wm * (16 * MTW) + r) * 64;
    bf16x8 wf[2][2], xf[2][MB];
#pragma unroll
    for (int nb = 0; nb < 2; ++nb) wf[0][nb] = *(const bf16x8*)(sWr + nb * 32 * 64 + xs[0]);
#pragma unroll
    for (int mb = 0; mb < MB; ++mb) xf[0][mb] = *(const bf16x8*)(sAr + mb * 32 * 64 + xs[0]);
    __builtin_amdgcn_sched_barrier(0);
#pragma unroll
    for (int s = 0; s < 4; ++s) {
      if (s < 3) {
#pragma unroll
        for (int nb = 0; nb < 2; ++nb) wf[(s + 1) & 1][nb] = *(const bf16x8*)(sWr + nb * 32 * 64 + xs[s + 1]);
#pragma unroll
        for (int mb = 0; mb < MB; ++mb) xf[(s + 1) & 1][mb] = *(const bf16x8*)(sAr + mb * 32 * 64 + xs[s + 1]);
      }
      if (s == 1 && kt + 1 < nk) {
#pragma unroll
        for (int i = 0; i < AI; ++i) *(u32x4*)(nA + (r0 + 64 * i) * 64 + c8s) = ra[i];
      }
      if (s == 2 && kt + 1 < nk) {
#pragma unroll
        for (int i = 0; i < 4; ++i) *(u32x4*)(nW + (r0 + 64 * i) * 64 + c8s) = rw[i];
      }
      if (s == 2 && kt + 2 < nk) G_LOAD();
      __builtin_amdgcn_sched_barrier(0);
#pragma unroll
      for (int mb = 0; mb < MB; ++mb)
#pragma unroll
        for (int nb = 0; nb < 2; ++nb)
          acc[nb][mb] = __builtin_amdgcn_mfma_f32_32x32x16_bf16(wf[s & 1][nb], xf[s & 1][mb], acc[nb][mb], 0, 0, 0);
    }
    __syncthreads();
  }
  if (has_next) {
    ga = (unsigned)((const unsigned char*)A - wsb) + (unsigned)((m0n + r0) * lda + c8) * 2u;
    gw = (unsigned)((const unsigned char*)W - wsb) + (unsigned)((n0n + r0) * K + c8) * 2u;
    G_LOAD();
  }
#undef G_LOAD
#undef G_STORE
  {
    unsigned char* ep = smem + G_STAGE + wv * 8192;
    constexpr int ROWS = 16 * MTW;
    if (epi == 0) {
      constexpr int PASSES = (ROWS * 128 > 8192) ? 2 : 1, RP = ROWS / PASSES, MBP = MB / PASSES;
#pragma unroll
      for (int ps_ = 0; ps_ < PASSES; ++ps_) {
#pragma unroll
        for (int mbl = 0; mbl < MBP; ++mbl) {
          const int mb = ps_ * MBP + mbl;
          const int row = mbl * 32 + r;
#pragma unroll
          for (int nb = 0; nb < 2; ++nb)
#pragma unroll
            for (int g4 = 0; g4 < 4; ++g4) {
              const int c8i = nb * 8 + 2 * g4 + hf;
              u32x2 v = {cvt_pk(acc[nb][mb][4 * g4 + 0], acc[nb][mb][4 * g4 + 1]), cvt_pk(acc[nb][mb][4 * g4 + 2], acc[nb][mb][4 * g4 + 3])};
              *(u32x2*)(ep + row * 128 + ((c8i ^ ((row & 7) << 1)) << 3)) = v;
            }
        }
#pragma unroll
        for (int i = 0; i < RP / 8; ++i) {
          const int row = i * 8 + (lane >> 3), c16 = lane & 7;
          const u32x4 v = *(const u32x4*)(ep + row * 128 + ((c16 ^ (row & 7)) << 4));
          *(u32x4*)(out + (size_t)(m0 + wm * ROWS + ps_ * RP + row) * ldo + n0 + wn * 64 + c16 * 8) = v;
        }
      }
    } else {
#pragma unroll
      for (int mb = 0; mb < MB; ++mb) {
        const int row = mb * 32 + r;
#pragma unroll
        for (int nb = 0; nb < 2; ++nb)
#pragma unroll
          for (int gg = 0; gg < 2; ++gg) {
            const int c8i = nb * 4 + 2 * gg + hf;
            const float a0 = silu_f(acc[nb][mb][4 * gg + 0]) * acc[nb][mb][8 + 4 * gg + 0];
            const float a1 = silu_f(acc[nb][mb][4 * gg + 1]) * acc[nb][mb][8 + 4 * gg + 1];
            const float a2 = silu_f(acc[nb][mb][4 * gg + 2]) * acc[nb][mb][8 + 4 * gg + 2];
            const float a3 = silu_f(acc[nb][mb][4 * gg + 3]) * acc[nb][mb][8 + 4 * gg + 3];
            u32x2 v = {cvt_pk(a0, a1), cvt_pk(a2, a3)};
            *(u32x2*)(ep + row * 64 + ((c8i ^ ((row & 3) << 1)) << 3)) = v;
          }
      }
#pragma unroll
      for (int i = 0; i < ROWS / 16; ++i) {
        const int row = i * 16 + (lane >> 2), c16 = lane & 3;
        const u32x4 v = *(const u32x4*)(ep + row * 64 + ((c16 ^ (row & 3)) << 4));
        *(u32x4*)(out + (size_t)(m0 + wm * ROWS + row) * ldo + ((n0 + wn * 64) >> 1) + c16 * 8) = v;
      }
    }
  }
}

struct GemmD { const u16* A; int lda; const u16* W; int K, N; u16* out; int ldo, epi; };

DI void phase_gemm(const unsigned char* wsb, unsigned char* smem, int bid, int nb, const GemmD& g0, const GemmD& g1, bool with_ctx) {
  const int n0t = g0.N >> 8, n1t = g1.N >> 8;
  const int big0 = 64 * n0t, big1 = 64 * n1t, mini0 = with_ctx ? 4 * n0t : 0, mini1 = with_ctx ? 4 * n1t : 0;
  int rem = big0 % nb;
  if (rem * 2 > nb) rem = 0;
  const int full0 = big0 - rem, half0 = 2 * rem;
  const int total = full0 + half0 + big1 + mini0 + mini1;
  u32x4 ra[4], rw[4];
#pragma unroll
  for (int i = 0; i < 4; ++i) { ra[i] = (u32x4){0u, 0u, 0u, 0u}; rw[i] = (u32x4){0u, 0u, 0u, 0u}; }
  bool pre = false;
  for (int tile = bid; tile < total; tile += nb) {
    int id = tile; bool sec = false; int kind = 0;
    if (id < full0) {}
    else if (id < full0 + half0) { id -= full0; kind = 1; }
    else if (id < full0 + half0 + big1) { id -= full0 + half0; sec = true; }
    else if (id < full0 + half0 + big1 + mini0) { id -= full0 + half0 + big1; kind = 2; }
    else { id -= full0 + half0 + big1 + mini0; sec = true; kind = 2; }
    const u16* A = sec ? g1.A : g0.A; const int lda = sec ? g1.lda : g0.lda;
    const u16* W = sec ? g1.W : g0.W; const int K = sec ? g1.K : g0.K;
    u16* out = sec ? g1.out : g0.out; const int ldo = sec ? g1.ldo : g0.ldo; const int epi = sec ? g1.epi : g0.epi;
    if (kind == 0) {
      const int mt = id & 63, nt = id >> 6;
      const int idn = tile + nb; const bool nxt = !sec && idn < full0;
      gemm_tile<8>(wsb, smem, A, lda, W, K, out, ldo, epi, N_CTX + mt * 256, nt * 256, ra, rw, pre, nxt, N_CTX + (idn & 63) * 256, (idn >> 6) * 256);
      pre = nxt;
    }
    else if (kind == 1) {
      const int big = full0 + (id >> 1); const int mt = big & 63, nt = big >> 6;
      gemm_tile<4>(wsb, smem, A, lda, W, K, out, ldo, epi, N_CTX + mt * 256 + (id & 1) * 128, nt * 256, ra, rw, false, false, 0, 0);
    }
    else { const int mt = id & 3, nt = id >> 2; gemm_tile<2>(wsb, smem, A, lda, W, K, out, ldo, epi, mt * 64, nt * 256, ra, rw, false, false, 0, 0); }
  }
}

DI void phase_abprep(const Params& p, int bid, int nb, int li) {
  const int lane = TIDX & 63, wv = TIDX >> 6;
  const float* qn = p.q_norm + li * 256; const float* kvn = p.kv_norm + li * 128;
  const float* gq = p.gq_norm + li * 64; const float* gk = p.gk_norm + li * 64;
  for (int t = bid * NWAVE + wv; t < T_TOK; t += nb * NWAVE) {
    const u16* Pr = pP + (size_t)t * 1280;
    const bool lat = t >= N_CTX; const int pos = t - N_CTX;
    {
      uint2 v = *(const uint2*)(Pr + lane * 4);
      float f0 = blo(v.x), f1 = bhi(v.x), f2 = blo(v.y), f3 = bhi(v.y);
      float ss = wave_sum(f0 * f0 + f1 * f1 + f2 * f2 + f3 * f3);
      float rs = rsqrtf(ss * (1.f / 256) + 1e-6f);
      float4 g = *(const float4*)(qn + lane * 4);
      uint2 o = {pack2(f0 * rs * g.x, f1 * rs * g.y), pack2(f2 * rs * g.z, f3 * rs * g.w)};
      *(uint2*)(pCQN + (size_t)t * 256 + lane * 4) = o;
    }
    {
      unsigned v = *(const unsigned*)(Pr + 256 + lane * 2);
      float f0 = blo(v), f1 = bhi(v);
      float ss = wave_sum(f0 * f0 + f1 * f1);
      float rs = rsqrtf(ss * (1.f / 128) + 1e-6f);
      *(unsigned*)(pCKVN + (size_t)t * 128 + lane * 2) = pack2(f0 * rs * kvn[lane * 2], f1 * rs * kvn[lane * 2 + 1]);
    }
    if (lane < 16) {
      float x1 = bf2f(Pr[384 + lane]), x2 = bf2f(Pr[400 + lane]);
      float o1 = x1, o2 = x2;
      if (lat) { float cs = pcosA[pos * 16 + lane], sn = psinA[pos * 16 + lane]; o1 = x1 * cs - x2 * sn; o2 = x1 * sn + x2 * cs; }
      pKR[(size_t)t * 32 + lane] = f2bf(o1); pKR[(size_t)t * 32 + 16 + lane] = f2bf(o2);
    }
    float cs = 1.f, sn = 0.f;
    if (lat) { cs = pcosH[pos * 32 + (lane & 31)]; sn = psinH[pos * 32 + (lane & 31)]; }
    for (int h = 0; h < 10; ++h) {
      const bool isq = h < 8;
      float xv = bf2f(Pr[(isq ? 416 + h * 64 : 928 + (h - 8) * 64) + lane]);
      float ss = wave_sum(xv * xv);
      float rs = rsqrtf(ss * (1.f / 64) + 1e-6f);
      float y = xv * rs * (isq ? gq[lane] : gk[lane]);
      float pr = __shfl_xor(y, 32, 64);
      float o = (lane < 32) ? (y * cs - pr * sn) : (pr * sn + y * cs);
      if (isq) pQB[(size_t)t * 512 + h * 64 + lane] = f2bf(o);
      else pKB[(size_t)t * 128 + (h - 8) * 64 + lane] = f2bf(o);
    }
  }
}

DI void phase_cdprep(const Params& p, int bid, int nb) {
  const int lane = TIDX & 63, wv = TIDX >> 6;
  for (int t = N_CTX + bid * NWAVE + wv; t < T_TOK; t += nb * NWAVE) {
    u16* Pr = pP + (size_t)t * 2304;
    const int pos = t - N_CTX;
    const int j = lane & 31;
    const float cs = pcosH[pos * 32 + j], sn = psinH[pos * 32 + j];
    for (int it = 0; it < 5; ++it) {
      const int h = it * 2 + (lane >> 5);
      u16* hp = Pr + h * 64;
      float x1 = bf2f(hp[j]), x2 = bf2f(hp[32 + j]);
      hp[j] = f2bf(x1 * cs - x2 * sn); hp[32 + j] = f2bf(x1 * sn + x2 * cs);
    }
  }
}

struct HG {
  const u16* q; int ldq;
  const u16* k1; int ldk1, k1hs;
  const u16* k2; int ldk2;
  const u16* v; int ldv, vhs;
  int group, mode, ropeq, ocol;
  float scale; const float* sink; const float* rpb;
};

template <int DQK>
DI void attn_naive_item(const Params& p, const HG& g, int t, int h) {
  float q[DQK];
  const u16* qp = g.q + (size_t)t * g.ldq + h * DQK;
#pragma unroll
  for (int c = 0; c < DQK / 8; ++c) {
    uint4 v = *(const uint4*)(qp + c * 8);
    q[c * 8 + 0] = blo(v.x); q[c * 8 + 1] = bhi(v.x); q[c * 8 + 2] = blo(v.y); q[c * 8 + 3] = bhi(v.y);
    q[c * 8 + 4] = blo(v.z); q[c * 8 + 5] = bhi(v.z); q[c * 8 + 6] = blo(v.w); q[c * 8 + 7] = bhi(v.w);
  }
  const bool lat = t >= N_CTX; const int pos = t - N_CTX;
  if (DQK == 96) {
    if (g.ropeq && lat) {
#pragma unroll
      for (int j = 0; j < 16; ++j) {
        float cs = pcosA[pos * 16 + j], sn = psinA[pos * 16 + j];
        float x1 = q[64 + j], x2 = q[80 + j];
        q[64 + j] = x1 * cs - x2 * sn; q[80 + j] = x1 * sn + x2 * cs;
      }
    }
  }
  float o[64];
#pragma unroll
  for (int d = 0; d < 64; ++d) o[d] = 0.f;
  float m = -3.0e38f, l = 0.f;
  const int kvh = h / g.group;
  const int row = pos >> 6, col = pos & 63;
  const int r0 = min(max(row - 4, 0), 248), c0 = min(max(col - 8, 0), 48);
  int ncand = N_CTX;
  if (lat) ncand = (g.mode == 0) ? T_TOK : (g.mode == 1 ? N_CTX + 257 : N_CTX + 128);
  for (int ci = 0; ci < ncand; ++ci) {
    int key = ci; float bias = 0.f; bool valid = true;
    if (ci >= N_CTX) {
      if (g.mode == 1) { int kp = pos - 128 + (ci - N_CTX); valid = (kp >= 0) && (kp < S_LAT); key = N_CTX + kp; }
      else if (g.mode == 2) {
        int n = ci - N_CTX; int kr = r0 + (n >> 4), kc = c0 + (n & 15);
        key = N_CTX + kr * 64 + kc;
        bias = g.rpb[h * 465 + (kr - row + 7) * 31 + (kc - col + 15)];
      }
    }
    if (!valid) continue;
    const u16* kp1 = g.k1 + (size_t)key * g.ldk1 + kvh * g.k1hs;
    float s = 0.f;
#pragma unroll
    for (int c = 0; c < 8; ++c) {
      uint4 v = *(const uint4*)(kp1 + c * 8);
      s += q[c * 8 + 0] * blo(v.x) + q[c * 8 + 1] * bhi(v.x) + q[c * 8 + 2] * blo(v.y) + q[c * 8 + 3] * bhi(v.y)
         + q[c * 8 + 4] * blo(v.z) + q[c * 8 + 5] * bhi(v.z) + q[c * 8 + 6] * blo(v.w) + q[c * 8 + 7] * bhi(v.w);
    }
    if (DQK == 96) {
      const u16* kp2 = g.k2 + (size_t)key * g.ldk2;
#pragma unroll
      for (int c = 0; c < 4; ++c) {
        uint4 v = *(const uint4*)(kp2 + c * 8);
        s += q[64 + c * 8 + 0] * blo(v.x) + q[64 + c * 8 + 1] * bhi(v.x) + q[64 + c * 8 + 2] * blo(v.y) + q[64 + c * 8 + 3] * bhi(v.y)
           + q[64 + c * 8 + 4] * blo(v.z) + q[64 + c * 8 + 5] * bhi(v.z) + q[64 + c * 8 + 6] * blo(v.w) + q[64 + c * 8 + 7] * bhi(v.w);
      }
    }
    s = s * g.scale + bias;
    const float mn = fmaxf(m, s);
    const float a = __expf(m - mn), pe = __expf(s - mn);
    l = l * a + pe; m = mn;
    const u16* vp = g.v + (size_t)key * g.ldv + kvh * g.vhs;
#pragma unroll
    for (int c = 0; c < 8; ++c) {
      uint4 v = *(const uint4*)(vp + c * 8);
      o[c * 8 + 0] = o[c * 8 + 0] * a + pe * blo(v.x); o[c * 8 + 1] = o[c * 8 + 1] * a + pe * bhi(v.x);
      o[c * 8 + 2] = o[c * 8 + 2] * a + pe * blo(v.y); o[c * 8 + 3] = o[c * 8 + 3] * a + pe * bhi(v.y);
      o[c * 8 + 4] = o[c * 8 + 4] * a + pe * blo(v.z); o[c * 8 + 5] = o[c * 8 + 5] * a + pe * bhi(v.z);
      o[c * 8 + 6] = o[c * 8 + 6] * a + pe * blo(v.w); o[c * 8 + 7] = o[c * 8 + 7] * a + pe * bhi(v.w);
    }
  }
  if (g.sink) {
    const float s = g.sink[h];
    const float mn = fmaxf(m, s);
    const float a = __expf(m - mn), pe = __expf(s - mn);
    l = l * a + pe;
#pragma unroll
    for (int d = 0; d < 64; ++d) o[d] *= a;
  }
  const float il = 1.f / l;
  u16* op = pO + (size_t)t * DM + g.ocol + h * 64;
#pragma unroll
  for (int c = 0; c < 8; ++c) {
    uint4 v;
    v.x = pack2(o[c * 8 + 0] * il, o[c * 8 + 1] * il); v.y = pack2(o[c * 8 + 2] * il, o[c * 8 + 3] * il);
    v.z = pack2(o[c * 8 + 4] * il, o[c * 8 + 5] * il); v.w = pack2(o[c * 8 + 6] * il, o[c * 8 + 7] * il);
    *(uint4*)(op + c * 8) = v;
  }
}

DI void make_hg(const Params& p, int l, HG& ga, HG& gb) {
  const int li = l >> 1;
  if ((l & 1) == 0) {
    ga.q = pQA; ga.ldq = 768; ga.k1 = pKVA; ga.ldk1 = 1024; ga.k1hs = 128; ga.k2 = pKR; ga.ldk2 = 32;
    ga.v = pKVA + 64; ga.ldv = 1024; ga.vhs = 128; ga.group = 1; ga.mode = 0; ga.ropeq = 1; ga.ocol = 0;
    ga.scale = 0.10206207261596575f; ga.sink = nullptr; ga.rpb = nullptr;
    gb.q = pQB; gb.ldq = 512; gb.k1 = pKB; gb.ldk1 = 128; gb.k1hs = 64; gb.k2 = nullptr; gb.ldk2 = 0;
    gb.v = pP + 1056; gb.ldv = 1280; gb.vhs = 64; gb.group = 4; gb.mode = 0; gb.ropeq = 0; gb.ocol = 512;
    gb.scale = 0.125f; gb.sink = nullptr; gb.rpb = nullptr;
  } else {
    ga.q = pP; ga.ldq = 2304; ga.k1 = pP + 512; ga.ldk1 = 2304; ga.k1hs = 64; ga.k2 = nullptr; ga.ldk2 = 0;
    ga.v = pP + 640; ga.ldv = 2304; ga.vhs = 64; ga.group = 4; ga.mode = 1; ga.ropeq = 0; ga.ocol = 0;
    ga.scale = 0.125f; ga.sink = p.sink + li * 8; ga.rpb = nullptr;
    gb.q = pP + 768; gb.ldq = 2304; gb.k1 = pP + 1280; gb.ldk1 = 2304; gb.k1hs = 64; gb.k2 = nullptr; gb.ldk2 = 0;
    gb.v = pP + 1792; gb.ldv = 2304; gb.vhs = 64; gb.group = 1; gb.mode = 2; gb.ropeq = 0; gb.ocol = 512;
    gb.scale = 0.125f; gb.sink = nullptr; gb.rpb = p.rpb + li * 8 * 465;
  }
}

DI void phase_attn_naive(const Params& p, int bid, int nb, int l) {
  HG ga, gb; make_hg(p, l, ga, gb);
  const int nchunks = 16 * (T_TOK / 256);
  const int t0 = (l == 3) ? 1 : 0;
  for (int ch = bid; ch < nchunks; ch += nb) {
    const int hh = ch % 16, tc = ch / 16;
    if (tc < t0) continue;
    const int t = tc * 256 + TIDX;
    if (hh < 8) {
      if ((l & 1) == 0) attn_naive_item<96>(p, ga, t, hh);
      else attn_naive_item<64>(p, ga, t, hh);
    } else attn_naive_item<64>(p, gb, t, hh - 8);
  }
}


DI int crow(int i, int hf) { return (i & 3) + 8 * (i >> 2) + 4 * hf; }
DI float fexp2(float x) { return __builtin_amdgcn_exp2f(x); }

template <int DQK>
DI void attn_fast_item(const Params& p, unsigned char* smem, const HG& g, int qt, int h, int tid) {
  constexpr int KST = DQK + 8, NKK = DQK / 16, CPR = DQK / 8, KCH = (64 * CPR + NTHR - 1) / NTHR;
  constexpr int VOFF = 64 * KST * 2;
  constexpr int STAGE = VOFF + 64 * 68 * 2;
  const int lane = tid & 63, wv = tid >> 6, r = lane & 31, hf = lane >> 5;
  const int t = qt * 256 + wv * 32 + r;
  const bool lat = qt >= 1;
  const int qpos = t - N_CTX;
  const int kvh = h / g.group;
  const int mode = g.mode;
  const float sc = g.scale * 1.4426950408889634f;
  bf16x8 qf[NKK];
  {
    const u16* qp = g.q + (size_t)t * g.ldq + h * DQK + hf * 8;
#pragma unroll
    for (int kk = 0; kk < NKK; ++kk) qf[kk] = *(const bf16x8*)(qp + kk * 16);
    if (DQK == 96) {
      if (g.ropeq && lat) {
        bf16x8 a = qf[NKK - 2], b = qf[NKK - 1];
#pragma unroll
        for (int i = 0; i < 8; ++i) {
          const float cs = pcosA[qpos * 16 + 8 * hf + i], sn = psinA[qpos * 16 + 8 * hf + i];
          const float x1 = bf2f((u16)a[i]), x2 = bf2f((u16)b[i]);
          a[i] = (short)f2bf(x1 * cs - x2 * sn); b[i] = (short)f2bf(x1 * sn + x2 * cs);
        }
        qf[NKK - 2] = a; qf[NKK - 1] = b;
      }
    }
#pragma unroll
    for (int kk = 0; kk < NKK; ++kk) {
      u32x4 w = __builtin_bit_cast(u32x4, qf[kk]);
#pragma unroll
      for (int i = 0; i < 4; ++i) w[i] = cvt_pk(blo(w[i]) * sc, bhi(w[i]) * sc);
      qf[kk] = __builtin_bit_cast(bf16x8, w);
    }
  }
  int ntiles = 4, lat_tok0 = N_CTX;
  if (lat) {
    if (mode == 0) ntiles = T_TOK / 64;
    else if (mode == 1) {
      const int s0 = (qt - 1) * 256; const int lo = max(0, s0 - 128), hi = min(S_LAT, s0 + 384);
      ntiles = 4 + ((hi - lo) >> 6); lat_tok0 = N_CTX + lo;
    } else {
      const int rr = 4 * (qt - 1); const int rlo = min(max(rr - 4, 0), 248), rhi = min(max(rr - 1, 0), 248) + 7;
      ntiles = 4 + (rhi - rlo + 1); lat_tok0 = N_CTX + rlo * 64;
    }
  }
  const bool masked_mode = lat && (mode != 0);
  const int qrow = qpos >> 6, qcol = qpos & 63;
  const int r0q = min(max(qrow - 4, 0), 248), c0q = min(max(qcol - 8, 0), 48);
  unsigned koff[KCH], kstr[KCH]; int kdst[KCH];
  const unsigned k1b = (unsigned)((const unsigned char*)g.k1 - p.ws), k2b = (unsigned)((const unsigned char*)g.k2 - p.ws);
#pragma unroll
  for (int i = 0; i < KCH; ++i) {
    const int q = min(tid + NTHR * i, 64 * CPR - 1); const int row = q / CPR, cc = q % CPR;
    if (DQK == 64 || cc < 8) { koff[i] = k1b + (unsigned)(row * g.ldk1 + kvh * g.k1hs + cc * 8) * 2u; kstr[i] = (unsigned)g.ldk1 * 2u; }
    else { koff[i] = k2b + (unsigned)(row * g.ldk2 + (cc - 8) * 8) * 2u; kstr[i] = (unsigned)g.ldk2 * 2u; }
    kdst[i] = (row * KST + cc * 8) * 2;
  }
  const int kp2 = tid & 31, vc = (tid >> 5) & 7;
  const bool vact = tid < 256;
  bool kact[KCH];
#pragma unroll
  for (int i = 0; i < KCH; ++i) kact[i] = (tid + NTHR * i) < 64 * CPR;
  const unsigned voff = (unsigned)((const unsigned char*)g.v - p.ws) + (unsigned)((2 * kp2) * g.ldv + kvh * g.vhs + vc * 8) * 2u;
  const unsigned vstr = (unsigned)g.ldv * 2u;
  const int vdst = VOFF + ((8 * vc) * 68 + 2 * kp2) * 2;
  const int kread = (r * KST + 8 * hf) * 2;
  const int vread = VOFF + (r * 68 + 4 * hf) * 2;

  u32x4 kreg[KCH], vreg0 = {0u, 0u, 0u, 0u}, vreg1 = {0u, 0u, 0u, 0u};
#pragma unroll
  for (int i = 0; i < KCH; ++i) kreg[i] = (u32x4){0u, 0u, 0u, 0u};
  auto tile_tok = [&](int i) { return (i < 4) ? 64 * i : lat_tok0 + 64 * (i - 4); };
#define ATT_LOAD(tok) { _Pragma("unroll") for (int i_ = 0; i_ < KCH; ++i_) if (kact[i_]) kreg[i_] = *(const u32x4*)(p.ws + (koff[i_] + (unsigned)(tok) * kstr[i_])); \
    if (vact) { vreg0 = *(const u32x4*)(p.ws + (voff + (unsigned)(tok) * vstr)); vreg1 = *(const u32x4*)(p.ws + (voff + (unsigned)(tok) * vstr + vstr)); } }
#define ATT_STORE(bufoff) { unsigned char* sb_ = smem + (bufoff); \
    _Pragma("unroll") for (int i_ = 0; i_ < KCH; ++i_) if (kact[i_]) *(u32x4*)(sb_ + kdst[i_]) = kreg[i_]; \
    if (vact) { _Pragma("unroll") for (int i_ = 0; i_ < 4; ++i_) { \
      *(unsigned*)(sb_ + vdst + (2 * i_) * 136) = __builtin_amdgcn_perm(vreg1[i_], vreg0[i_], 0x05040100u); \
      *(unsigned*)(sb_ + vdst + (2 * i_ + 1) * 136) = __builtin_amdgcn_perm(vreg1[i_], vreg0[i_], 0x07060302u); } } }

  f32x16 O0, O1, NEGM;
#pragma unroll
  for (int i = 0; i < 16; ++i) { O0[i] = 0.f; O1[i] = 0.f; NEGM[i] = 0.f; }
  float l = 0.f;

  ATT_LOAD(0);
  ATT_STORE(0);
  __syncthreads();
  for (int it = 0; it < ntiles; ++it) {
    const int tok = tile_tok(it);
    const bool more = it + 1 < ntiles;
    if (more) { const int ntok = tile_tok(it + 1); ATT_LOAD(ntok); }
    const unsigned char* sb = smem + (it & 1) * STAGE;
    bool wave_active = true;
    if (masked_mode && it >= 4) {
      const int q0 = (qt - 1) * 256 + __builtin_amdgcn_readfirstlane(wv) * 32;
      const int kt0u = tok - N_CTX;
      if (mode == 1) wave_active = (kt0u <= q0 + 31 + 128) && (kt0u + 63 >= q0 - 128);
      else { const int r0w = min(max((q0 >> 6) - 4, 0), 248); const int kru = kt0u >> 6; wave_active = (kru >= r0w) && (kru < r0w + 8); }
    }
    if (wave_active) {
    auto compute_S = [&](f32x16& S0, f32x16& S1) {
      bf16x8 kf0[NKK], kf1[NKK];
#pragma unroll
      for (int kk = 0; kk < 2; ++kk) {
        kf0[kk] = *(const bf16x8*)(sb + kread + kk * 32);
        kf1[kk] = *(const bf16x8*)(sb + kread + 32 * KST * 2 + kk * 32);
      }
      __builtin_amdgcn_sched_barrier(0);
      S0 = NEGM; S1 = NEGM;
#pragma unroll
      for (int kk = 0; kk < NKK; ++kk) {
        S0 = __builtin_amdgcn_mfma_f32_32x32x16_bf16(kf0[kk], qf[kk], S0, 0, 0, 0);
        S1 = __builtin_amdgcn_mfma_f32_32x32x16_bf16(kf1[kk], qf[kk], S1, 0, 0, 0);
        if (kk + 2 < NKK) {
          kf0[kk + 2] = *(const bf16x8*)(sb + kread + (kk + 2) * 32);
          kf1[kk + 2] = *(const bf16x8*)(sb + kread + 32 * KST * 2 + (kk + 2) * 32);
        }
        __builtin_amdgcn_sched_barrier(0);
      }
      if (masked_mode && it >= 4) {
        const int kt0 = tok - N_CTX;
        if (mode == 1) {
#pragma unroll
          for (int i = 0; i < 16; ++i) {
            const int k0p = kt0 + crow(i, hf), k1p = k0p + 32;
            int d0 = qpos - k0p; d0 = d0 < 0 ? -d0 : d0; int d1 = qpos - k1p; d1 = d1 < 0 ? -d1 : d1;
            S0[i] = (d0 <= 128) ? S0[i] : -1.0e30f;
            S1[i] = (d1 <= 128) ? S1[i] : -1.0e30f;
          }
        } else {
          const int kr = kt0 >> 6;
          const bool vrow = (kr >= r0q) && (kr < r0q + 8);
          const float* rp = g.rpb + h * 465 + (kr - qrow + 7) * 31 + (15 - qcol);
#pragma unroll
          for (int i = 0; i < 16; ++i) {
            const int kc0 = crow(i, hf), kc1 = kc0 + 32;
            const bool v0 = vrow && (kc0 >= c0q) && (kc0 < c0q + 16);
            const bool v1 = vrow && (kc1 >= c0q) && (kc1 < c0q + 16);
            float b0 = 0.f, b1 = 0.f;
            if (v0) b0 = rp[kc0];
            if (v1) b1 = rp[kc1];
            S0[i] = v0 ? S0[i] + b0 * 1.4426950408889634f : -1.0e30f;
            S1[i] = v1 ? S1[i] + b1 * 1.4426950408889634f : -1.0e30f;
          }
        }
      }
    };
    f32x16 S0, S1;
    compute_S(S0, S1);
    u32x2 vfa[8], vfb[8];
#pragma unroll
    for (int j = 0; j < 4; ++j) {
      vfa[j] = *(const u32x2*)(sb + vread + j * 16);
      vfb[j] = *(const u32x2*)(sb + vread + 32 * 136 + j * 16);
    }
    __builtin_amdgcn_sched_barrier(0);
    float ps = 0.f;
#pragma unroll
    for (int i = 0; i < 16; ++i) {
      S0[i] = fexp2(S0[i]); S1[i] = fexp2(S1[i]);
      ps += S0[i]; asm volatile("" : "+v"(ps));
      ps += S1[i]; asm volatile("" : "+v"(ps));
    }
    if (it == 0 || __builtin_amdgcn_ballot_w64(!(ps < 1.0e30f)) != 0ull) {
      compute_S(S0, S1);
      float mx = __builtin_amdgcn_fmed3f(S0[0], S1[0], __builtin_inff());
#pragma unroll
      for (int i = 1; i < 16; ++i) { mx = __builtin_amdgcn_fmed3f(mx, S0[i], __builtin_inff()); mx = __builtin_amdgcn_fmed3f(mx, S1[i], __builtin_inff()); }
      mx = __builtin_amdgcn_fmed3f(mx, __shfl_xor(mx, 32, 64), __builtin_inff());
      const float dl = (it == 0) ? mx : (mx > 0.f ? mx : 0.f);
#pragma unroll
      for (int i = 0; i < 16; ++i) NEGM[i] -= dl;
      if (it > 0) {
        const float a = fexp2(-dl);
        l *= a;
#pragma unroll
        for (int i = 0; i < 16; ++i) { O0[i] *= a; O1[i] *= a; }
      }
      ps = 0.f;
#pragma unroll
      for (int i = 0; i < 16; ++i) { S0[i] = fexp2(S0[i] - dl); S1[i] = fexp2(S1[i] - dl); ps += S0[i] + S1[i]; }
    }
    l += ps;
    __builtin_amdgcn_sched_barrier(0);
#pragma unroll
    for (int kb = 0; kb < 2; ++kb) {
#pragma unroll
      for (int s2 = 0; s2 < 2; ++s2) {
        u32x4 pk;
        if (kb == 0) { pk[0] = cvt_pk(S0[8 * s2 + 0], S0[8 * s2 + 1]); pk[1] = cvt_pk(S0[8 * s2 + 2], S0[8 * s2 + 3]); pk[2] = cvt_pk(S0[8 * s2 + 4], S0[8 * s2 + 5]); pk[3] = cvt_pk(S0[8 * s2 + 6], S0[8 * s2 + 7]); }
        else { pk[0] = cvt_pk(S1[8 * s2 + 0], S1[8 * s2 + 1]); pk[1] = cvt_pk(S1[8 * s2 + 2], S1[8 * s2 + 3]); pk[2] = cvt_pk(S1[8 * s2 + 4], S1[8 * s2 + 5]); pk[3] = cvt_pk(S1[8 * s2 + 6], S1[8 * s2 + 7]); }
        const bf16x8 pf = __builtin_bit_cast(bf16x8, pk);
        const int jj = 4 * kb + 2 * s2;
        u32x4 va, vb;
        va[0] = vfa[jj][0]; va[1] = vfa[jj][1]; va[2] = vfa[jj + 1][0]; va[3] = vfa[jj + 1][1];
        vb[0] = vfb[jj][0]; vb[1] = vfb[jj][1]; vb[2] = vfb[jj + 1][0]; vb[3] = vfb[jj + 1][1];
        O0 = __builtin_amdgcn_mfma_f32_32x32x16_bf16(__builtin_bit_cast(bf16x8, va), pf, O0, 0, 0, 0);
        O1 = __builtin_amdgcn_mfma_f32_32x32x16_bf16(__builtin_bit_cast(bf16x8, vb), pf, O1, 0, 0, 0);
        if (jj + 4 < 8) {
          vfa[jj + 4] = *(const u32x2*)(sb + vread + (jj + 4) * 16); vfa[jj + 5] = *(const u32x2*)(sb + vread + (jj + 5) * 16);
          vfb[jj + 4] = *(const u32x2*)(sb + vread + 32 * 136 + (jj + 4) * 16); vfb[jj + 5] = *(const u32x2*)(sb + vread + 32 * 136 + (jj + 5) * 16);
        }
        __builtin_amdgcn_sched_barrier(0);
      }
    }
    }
    if (more) ATT_STORE(((it + 1) & 1) * STAGE);
    __syncthreads();
  }
  l += __shfl_xor(l, 32, 64);
  if (g.sink) {
    const float rel = g.sink[h] * 1.4426950408889634f + NEGM[0];
    const float dl = rel > 0.f ? rel : 0.f;
    const float a2 = fexp2(-dl);
    l = l * a2 + fexp2(rel - dl);
#pragma unroll
    for (int i = 0; i < 16; ++i) { O0[i] *= a2; O1[i] *= a2; }
  }
  const float il = 1.f / l;
  u16* op = pO + (size_t)t * DM + g.ocol + h * 64 + 4 * hf;
#pragma unroll
  for (int g4 = 0; g4 < 4; ++g4) {
    u32x2 v0 = {cvt_pk(O0[4 * g4 + 0] * il, O0[4 * g4 + 1] * il), cvt_pk(O0[4 * g4 + 2] * il, O0[4 * g4 + 3] * il)};
    u32x2 v1 = {cvt_pk(O1[4 * g4 + 0] * il, O1[4 * g4 + 1] * il), cvt_pk(O1[4 * g4 + 2] * il, O1[4 * g4 + 3] * il)};
    *(u32x2*)(op + 8 * g4) = v0;
    *(u32x2*)(op + 32 + 8 * g4) = v1;
  }
#undef ATT_LOAD
#undef ATT_STORE
}

DI void phase_attn_fast(const Params& p, unsigned char* smem, int bid, int nb, int l) {
  HG ga, gb; make_hg(p, l, ga, gb);
  const int tid = TIDX;
  const int nitems = (l == 3) ? 1024 : 1040;
  for (int it = bid; it < nitems; it += nb) {
    int h16, qt;
    if (it < 1024) { const int b = it & 255, j = it >> 8; h16 = ((b & 15) + 8 * (j & 1)) & 15; qt = 1 + (b >> 4) + 16 * j; }
    else { h16 = it - 1024; qt = 0; }
    if (h16 < 8) {
      if ((l & 1) == 0) attn_fast_item<96>(p, smem, ga, qt, h16, tid);
      else attn_fast_item<64>(p, smem, ga, qt, h16, tid);
    } else attn_fast_item<64>(p, smem, gb, qt, h16 - 8, tid);
  }
}

#define XB_TMO      128
#define XB_XCNT(j)  (256  + 64 * (j))
#define XB_XSUB(j)  (1280 + 64 * (j))
#define XB_XGEN(j)  (2304 + 64 * (j))
#define XB_TOP      3328
#define XB_TOPGEN   3392
#define XCD_BAR_WORDS 3456
#define XB_SPIN_CAP (1u << 18)
#define LAS __attribute__((address_space(3)))
DI unsigned xb_ld(unsigned* p) { return __hip_atomic_load(p, __ATOMIC_RELAXED, __HIP_MEMORY_SCOPE_AGENT); }
DI unsigned xb_add(unsigned* p, unsigned v) { return __hip_atomic_fetch_add(p, v, __ATOMIC_RELAXED, __HIP_MEMORY_SCOPE_AGENT); }
DI unsigned xb_xcc_id() { return (unsigned)__builtin_amdgcn_s_getreg((3 << 11) | 20) & 0xFu; }
#define XB_SPIN(cond, bar) do { unsigned _sp = 0; while (cond) { __builtin_amdgcn_s_sleep(1); \
    if ((++_sp & 255u) == 0u) { if (xb_ld(&(bar)[XB_TMO])) break; if (_sp > XB_SPIN_CAP) { atomicAdd(&(bar)[XB_TMO], 1u); break; } } } } while (0)
struct XcdBarrier { unsigned* bar; unsigned x; volatile LAS unsigned* st; };
DI XcdBarrier xcd_barrier_post(unsigned* bar, volatile LAS unsigned* st) {
  XcdBarrier b; b.bar = bar; b.x = xb_xcc_id(); b.st = st;
  if (threadIdx.x == 0) (void)xb_add(&bar[XB_XCNT(b.x)], 1u);
  return b;
}
DI void xcd_barrier_complete(unsigned* bar, unsigned x, unsigned& nloc, unsigned& nx) {
  const unsigned G = gridDim.x * gridDim.y * gridDim.z;
  unsigned sum, cnt, mine, sp = 0u;
  for (;;) {
    sum = 0u; cnt = 0u; mine = 0u;
#pragma unroll
    for (unsigned j = 0; j < 16; ++j) { const unsigned c = xb_ld(&bar[XB_XCNT(j)]); sum += c; cnt += (c > 0u) ? 1u : 0u; mine = (j == x) ? c : mine; }
    if (sum == G) break;
    __builtin_amdgcn_s_sleep(1);
    if ((++sp & 255u) == 0u) { if (xb_ld(&bar[XB_TMO])) break; if (sp > XB_SPIN_CAP) { atomicAdd(&bar[XB_TMO], 1u); break; } }
  }
  nloc = mine > 0u ? mine : 1u; nx = cnt > 0u ? cnt : 1u;
}
DI void xcd_barrier(const XcdBarrier& b) {
  asm volatile("s_waitcnt vmcnt(0)" ::: "memory");
  __syncthreads();
  if (threadIdx.x == 0) {
    unsigned* bar = b.bar;
    __builtin_amdgcn_s_waitcnt(0);
    unsigned nloc = b.st[0], nx = b.st[1];
    if (nloc == 0u) { xcd_barrier_complete(bar, b.x, nloc, nx); b.st[0] = nloc; b.st[1] = nx; }
    const unsigned old = xb_add(&bar[XB_XSUB(b.x)], 1u);
    const unsigned gen = old / nloc;
    if (old + 1u == (gen + 1u) * nloc) {
      __builtin_amdgcn_fence(__ATOMIC_RELEASE, "agent");
      asm volatile("s_waitcnt vmcnt(0)" ::: "memory");
      const unsigned og = xb_add(&bar[XB_TOP], 1u);
      const unsigned tg = og / nx;
      if (og + 1u == (tg + 1u) * nx) xb_add(&bar[XB_TOPGEN], 1u);
      else XB_SPIN(xb_ld(&bar[XB_TOPGEN]) == tg, bar);
      __builtin_amdgcn_fence(__ATOMIC_ACQUIRE, "agent");
      xb_add(&bar[XB_XGEN(b.x)], 1u);
      asm volatile("s_waitcnt vmcnt(0)" ::: "memory");
    } else {
      XB_SPIN(xb_ld(&bar[XB_XGEN(b.x)]) == gen, bar);
      __builtin_amdgcn_fence(__ATOMIC_ACQUIRE, "agent");
      asm volatile("s_waitcnt vmcnt(0)" ::: "memory");
    }
  }
  __syncthreads();
}

__global__ void __launch_bounds__(NTHR, 2) mk(Params p, int lo, int hi) {
  __shared__ __attribute__((aligned(16))) unsigned char smem[SMEM_BYTES];
  cg::grid_group grid = cg::this_grid();
  const int bid = blockIdx.x, nb = gridDim.x;
#if !MULTI
  __shared__ uint4 xb_words;
  if (threadIdx.x == 0) xb_words = make_uint4(0u, 0u, 0u, 0u);
  __syncthreads();
  XcdBarrier xb = xcd_barrier_post((unsigned*)(p.ws + OFF_BAR), (volatile LAS unsigned*)&xb_words);
#endif
  for (int phv = lo; phv < hi && phv < NPH; ++phv) {
    const int ph = __builtin_amdgcn_readfirstlane(phv);
    bool did = true;
    if (ph == 0) { for (int rep = 0; rep < REP_PREP; ++rep) phase_prep(p, smem, bid, nb); }
    else if (ph == 1) phase_rowop(p, smem, bid, nb, false, true, false, 0, 0, 0.f, true, 0, 0);
    else {
      const int q = ph - 2, l = q / 12, s = q % 12, li = l >> 1;
      const bool ab = (l & 1) == 0;
      if (s == 2 || s == 8 || s == 11) {
        const int slot = (s == 2) ? 0 : (s == 8 ? 1 : 2);
        const float w = (s == 8) ? 1.0f : 0.5f;
        const bool last = (l == 3 && s == 11);
        const bool first = (l == 0 && s == 2);
        const int lpre = (s == 11) ? l + 1 : l;
        const int spre = (s == 11) ? 0 : slot + 1;
        phase_rowop(p, smem, bid, nb, true, first, last, l, slot, w, !last, lpre, spre);
      } else if (s == 4) {
        if (ab) { for (int rep = 0; rep < REP_MIXPREP; ++rep) phase_abprep(p, bid, nb, li); } else phase_cdprep(p, bid, nb);
      } else if (s == 6) {
        for (int rep = 0; rep < REP_ATTN; ++rep) phase_attn_fast(p, smem, bid, nb, l);
      } else if (s == 5 && !ab) {
        did = false;
      } else {
        GemmD g0, g1;
        g1.A = nullptr; g1.lda = 0; g1.W = nullptr; g1.K = 64; g1.N = 0; g1.out = nullptr; g1.ldo = 0; g1.epi = 0;
        if (s == 0 || s == 9) { g0.A = pH; g0.lda = DM; g0.W = pWgu + (size_t)(l * 2 + (s == 9)) * SZ_WGU; g0.K = DM; g0.N = 2 * DFF; g0.out = pACT; g0.ldo = DFF; g0.epi = 1; }
        else if (s == 1 || s == 10) { g0.A = pACT; g0.lda = DFF; g0.W = pWd + (size_t)(l * 2 + (s == 10)) * SZ_WD; g0.K = DFF; g0.N = DM; g0.out = pY; g0.ldo = DM; g0.epi = 0; }
        else if (s == 3) {
          g0.A = pH; g0.lda = DM; g0.K = DM; g0.out = pP; g0.epi = 0;
          if (ab) { g0.W = pWabin + li * SZ_ABIN; g0.N = 1280; g0.ldo = 1280; } else { g0.W = pWcdin + li * SZ_CDIN; g0.N = 2304; g0.ldo = 2304; }
        } else if (s == 5) {
          g0.A = pCQN; g0.lda = 256; g0.W = pWuq + li * SZ_UQ; g0.K = 256; g0.N = 768; g0.out = pQA; g0.ldo = 768; g0.epi = 0;
          g1.A = pCKVN; g1.lda = 128; g1.W = pWukv + li * SZ_UKV; g1.K = 128; g1.N = 1024; g1.out = pKVA; g1.ldo = 1024; g1.epi = 0;
        } else {
          g0.A = pO; g0.lda = DM; g0.W = ab ? pWabout + li * SZ_SQ : pWcdout + li * SZ_SQ; g0.K = DM; g0.N = DM; g0.out = pY; g0.ldo = DM; g0.epi = 0;
        }
        for (int rep = 0; rep < (((REP_GEMM_MASK >> s) & 1) ? REP_GEMM : 1); ++rep) phase_gemm(p.ws, smem, bid, nb, g0, g1, !(l == 3 && s >= 7));
        tail_convert(p, smem, bid, nb, l, s);
      }
    }
    #if MULTI
    if (did && ph + 1 < hi) grid.sync();
#else
    if (did && ph + 1 < hi) { if (ph == 0) grid.sync(); else { for (int rep = 0; rep < REP_SYNC; ++rep) xcd_barrier(xb); } }
#endif
  }
}

static inline size_t al256(size_t x) { return (x + 255) & ~(size_t)255; }

extern "C" void kernel_launch(void* const* d_in, const int* in_sizes, int n_in, void* d_out, int out_size,
                              void* d_ws, size_t ws_size, hipStream_t stream) {
  Params p;
  memset(&p, 0, sizeof(p));
  const float* x = (const float*)d_in[0];
  p.x = x; p.c = (const float*)d_in[1]; p.ctx = (const float*)d_in[2]; p.c_ctx = (const float*)d_in[3];
  p.ada_w = (const float*)d_in[4]; p.ada_b = (const float*)d_in[5]; p.norm_g = (const float*)d_in[6];
  const float* ffn_g = (const float*)d_in[7]; const float* ffn_u = (const float*)d_in[8]; const float* ffn_d = (const float*)d_in[9];
  const float* ab_w_in = (const float*)d_in[10]; p.q_norm = (const float*)d_in[11]; const float* w_uq = (const float*)d_in[12];
  p.kv_norm = (const float*)d_in[13]; const float* w_ukv = (const float*)d_in[14];
  p.gq_norm = (const float*)d_in[15]; p.gk_norm = (const float*)d_in[16];
  const float* ab_w_out = (const float*)d_in[17]; const float* cd_w_in = (const float*)d_in[18];
  p.sink = (const float*)d_in[19]; p.rpb = (const float*)d_in[20]; const float* cd_w_out = (const float*)d_in[21];
  p.out = (float*)d_out;

  p.ws = (unsigned char*)d_ws;
  p.ffn_g = ffn_g; p.ffn_u = ffn_u; p.ffn_d = ffn_d; p.ab_w_in = ab_w_in; p.w_uq = w_uq; p.w_ukv = w_ukv;
  p.ab_w_out = ab_w_out; p.cd_w_in = cd_w_in; p.cd_w_out = cd_w_out;
  const size_t off = WS_NEED;
  if (off > ws_size) { fprintf(stderr, "workspace too small: need %zu have %zu\n", off, ws_size); return; }

  static int grid_blocks = 0;
  if (!grid_blocks) {
    int dev = 0, cus = 0, per_cu = 0;
    hipGetDevice(&dev);
    hipDeviceGetAttribute(&cus, hipDeviceAttributeMultiprocessorCount, dev);
    hipOccupancyMaxActiveBlocksPerMultiprocessor(&per_cu, mk, NTHR, 0);
    if (per_cu > 1) per_cu = 1;
    if (per_cu < 1) per_cu = 1;
    grid_blocks = cus * per_cu;
  }
#if MULTI
  for (int ph = 0; ph < NPH; ++ph) {
    if (ph >= 2 && ((ph - 2) % 12) == 5 && (((ph - 2) / 12) & 1)) continue;
    hipLaunchKernelGGL(mk, dim3(grid_blocks), dim3(NTHR), 0, stream, p, ph, ph + 1);
  }
#else
  int lo = 0, hi = NPH;
  void* args[] = {&p, &lo, &hi};
  hipMemsetAsync((unsigned char*)d_ws + OFF_BAR, 0, 16384, stream);
  hipError_t e = hipLaunchCooperativeKernel((void*)mk, dim3(grid_blocks), dim3(NTHR), args, 0, stream);
  if (e != hipSuccess) fprintf(stderr, "cooperative launch failed: %s (grid %d)\n", hipGetErrorString(e), grid_blocks);
#endif
}
```
